# Optimizing an MI355X kernel written in HIP

```python
import jax, jax.numpy as jnp
from jax import lax
import numpy as np

D_MODEL = 1024
BATCH = 8
SEQ = 4096
DEPTH = 2

N_MIXERS = 2
N_ATTN_LAYERS = (DEPTH + 1) // 2
N_SGU_LAYERS = DEPTH // 2

HEAD_DIM = 64
N_Q_HEADS = D_MODEL // HEAD_DIM
N_KV_HEADS = N_Q_HEADS // 4
GQA_GROUP = N_Q_HEADS // N_KV_HEADS
WINDOW = 128
Q_BLOCK = WINDOW
ROPE_THETA = 10000.0
Q_WIDTH = N_Q_HEADS * HEAD_DIM
KV_WIDTH = N_KV_HEADS * HEAD_DIM
QKV_WIDTH = Q_WIDTH + 2 * KV_WIDTH

SGU_WIDTH = D_MODEL
SGU_GROUPS = 8
SGU_GROUP_DIM = SGU_WIDTH // SGU_GROUPS
SGU_CHUNK = 128

D_FF = ((8 * D_MODEL + 3 * 256 - 1) // (3 * 256)) * 256

EPS = 1e-6

kernel_name = "hybrid_swa_sink_gqa_chunked_sgu_swiglu"


def rmsnorm(x, g):
    xf = x.astype(jnp.float32)
    y = xf * lax.rsqrt(jnp.mean(xf * xf, axis=-1, keepdims=True) + EPS)
    return (y * g.astype(jnp.float32)).astype(x.dtype)


def layernorm(x, g, b):
    xf = x.astype(jnp.float32)
    mu = jnp.mean(xf, axis=-1, keepdims=True)
    var = jnp.mean(jnp.square(xf - mu), axis=-1, keepdims=True)
    y = (xf - mu) * lax.rsqrt(var + EPS)
    return (y * g.astype(jnp.float32) + b.astype(jnp.float32)).astype(x.dtype)


def rope(x, pos):
    half = HEAD_DIM // 2
    inv_freq = ROPE_THETA ** (-(jnp.arange(half, dtype=jnp.float32) * 2.0) / HEAD_DIM)
    ang = pos.astype(jnp.float32)[:, None] * inv_freq[None, :]
    cos = jnp.cos(ang)[None, :, None, :].astype(x.dtype)
    sin = jnp.sin(ang)[None, :, None, :].astype(x.dtype)
    x1, x2 = x[..., :half], x[..., half:]
    return jnp.concatenate([x1 * cos - x2 * sin, x2 * cos + x1 * sin], axis=-1)


def swa_sink_attention(h, w_qkv, b_qkv, sinks, w_o, b_o):
    B, S, _ = h.shape
    nb = S // Q_BLOCK
    T = Q_BLOCK
    qkv = h @ w_qkv + b_qkv
    q = qkv[..., :Q_WIDTH].reshape(B, S, N_Q_HEADS, HEAD_DIM)
    k = qkv[..., Q_WIDTH:Q_WIDTH + KV_WIDTH].reshape(B, S, N_KV_HEADS, HEAD_DIM)
    v = qkv[..., Q_WIDTH + KV_WIDTH:].reshape(B, S, N_KV_HEADS, HEAD_DIM)
    pos = jnp.arange(S, dtype=jnp.int32)
    q = rope(q, pos)
    k = rope(k, pos)
    qb = q.reshape(B, nb, T, N_KV_HEADS, GQA_GROUP, HEAD_DIM)
    kb = k.reshape(B, nb, T, N_KV_HEADS, HEAD_DIM)
    vb = v.reshape(B, nb, T, N_KV_HEADS, HEAD_DIM)
    pad = jnp.zeros_like(kb[:, :1])
    kk = jnp.concatenate([jnp.concatenate([pad, kb[:, :-1]], axis=1), kb], axis=2)
    vv = jnp.concatenate([jnp.concatenate([pad, vb[:, :-1]], axis=1), vb], axis=2)
    scale = HEAD_DIM ** -0.5
    s = jnp.einsum('bnqhgd,bnkhd->bnhgqk', qb, kk).astype(jnp.float32) * scale
    qpos = jnp.arange(T)[:, None] + T
    kpos = jnp.arange(2 * T)[None, :]
    band = (kpos <= qpos) & (qpos - kpos < WINDOW)
    blk = jnp.arange(nb)[:, None, None]
    valid = band[None] & ((blk * T + kpos[None] - T) >= 0)
    s = jnp.where(valid[None, :, None, None], s, -jnp.inf)
    sink = sinks.astype(jnp.float32).reshape(1, 1, N_KV_HEADS, GQA_GROUP, 1, 1)
    m = jnp.maximum(jnp.max(s, axis=-1, keepdims=True), sink)
    p = jnp.exp(s - m)
    denom = jnp.sum(p, axis=-1, keepdims=True) + jnp.exp(sink - m)
    probs = (p / denom).astype(vv.dtype)
    o = jnp.einsum('bnhgqk,bnkhd->bnqhgd', probs, vv).reshape(B, S, Q_WIDTH)
    return o @ w_o + b_o


def chunked_sgu(h, w_in, ln_g, ln_b, w_spatial, b_spatial, w_out):
    B, S, _ = h.shape
    nc = S // SGU_CHUNK
    z = jax.nn.gelu(h @ w_in)
    u, v = z[..., :SGU_WIDTH], z[..., SGU_WIDTH:]
    v = layernorm(v, ln_g, ln_b)
    vg = v.reshape(B, nc, SGU_CHUNK, SGU_GROUPS, SGU_GROUP_DIM)
    causal = jnp.tril(jnp.ones((SGU_CHUNK, SGU_CHUNK), dtype=w_spatial.dtype))
    ws = w_spatial * causal[None]
    mixed = jnp.einsum('gts,bnsgd->bntgd', ws, vg) + b_spatial.T[None, None, :, :, None]
    y = u * mixed.reshape(B, S, SGU_WIDTH)
    return y @ w_out


def swiglu(h, w_gate_up, w_down):
    gu = h @ w_gate_up
    return (jax.nn.silu(gu[..., :D_FF]) * gu[..., D_FF:]) @ w_down


def setup_inputs(seed: int = 0) -> dict:
    key = jax.random.key(seed)
    ks = jax.random.split(key, 20)
    f32 = jnp.float32

    def nrm(k, shape, scale):
        return jax.random.normal(k, shape, f32) * scale

    def gain(k, shape):
        return 1.0 + 0.02 * jax.random.normal(k, shape, f32)

    NA, NS = N_ATTN_LAYERS, N_SGU_LAYERS
    return {
        "x": jax.random.normal(ks[0], (BATCH, SEQ, D_MODEL), f32),
        "norm_mix_pre": gain(ks[1], (DEPTH, D_MODEL)),
        "norm_mix_post": gain(ks[2], (DEPTH, D_MODEL)),
        "norm_ffn_pre": gain(ks[3], (DEPTH, D_MODEL)),
        "norm_ffn_post": gain(ks[4], (DEPTH, D_MODEL)),
        "attn_w_qkv": nrm(ks[5], (NA, D_MODEL, QKV_WIDTH), D_MODEL ** -0.5),
        "attn_b_qkv": nrm(ks[6], (NA, QKV_WIDTH), 0.02),
        "attn_sinks": nrm(ks[7], (NA, N_Q_HEADS), 1.0),
        "attn_w_o": nrm(ks[8], (NA, Q_WIDTH, D_MODEL), Q_WIDTH ** -0.5),
        "attn_b_o": nrm(ks[9], (NA, D_MODEL), 0.02),
        "sgu_w_in": nrm(ks[10], (NS, D_MODEL, 2 * SGU_WIDTH), D_MODEL ** -0.5),
        "sgu_ln_g": gain(ks[11], (NS, SGU_WIDTH)),
        "sgu_ln_b": nrm(ks[12], (NS, SGU_WIDTH), 0.02),
        "sgu_w_spatial": nrm(ks[13], (NS, SGU_GROUPS, SGU_CHUNK, SGU_CHUNK), SGU_CHUNK ** -0.5),
        "sgu_b_spatial": 1.0 + nrm(ks[14], (NS, SGU_GROUPS, SGU_CHUNK), 0.02),
        "sgu_w_out": nrm(ks[15], (NS, SGU_WIDTH, D_MODEL), SGU_WIDTH ** -0.5),
        "ffn_w_gate_up": nrm(ks[16], (DEPTH, D_MODEL, 2 * D_FF), D_MODEL ** -0.5),
        "ffn_w_down": nrm(ks[17], (DEPTH, D_FF, D_MODEL), D_FF ** -0.5),
    }


def reference(x, norm_mix_pre, norm_mix_post, norm_ffn_pre, norm_ffn_post,
              attn_w_qkv, attn_b_qkv, attn_sinks, attn_w_o, attn_b_o,
              sgu_w_in, sgu_ln_g, sgu_ln_b, sgu_w_spatial, sgu_b_spatial, sgu_w_out,
              ffn_w_gate_up, ffn_w_down):
    for i in range(DEPTH):
        h = rmsnorm(x, norm_mix_pre[i])
        j = i // N_MIXERS
        if i % N_MIXERS == 0:
            m = swa_sink_attention(h, attn_w_qkv[j], attn_b_qkv[j], attn_sinks[j],
                                   attn_w_o[j], attn_b_o[j])
        else:
            m = chunked_sgu(h, sgu_w_in[j], sgu_ln_g[j], sgu_ln_b[j],
                            sgu_w_spatial[j], sgu_b_spatial[j], sgu_w_out[j])
        x = x + rmsnorm(m, norm_mix_post[i])
        h = rmsnorm(x, norm_ffn_pre[i])
        x = x + rmsnorm(swiglu(h, ffn_w_gate_up[i], ffn_w_down[i]), norm_ffn_post[i])
    return x
```

```cpp
#include <hip/hip_runtime.h>
#include <hip/hip_cooperative_groups.h>
#include <cstdio>
#include <cstdint>
namespace cg = cooperative_groups;
namespace pg8 {
#define PG8_LAS __attribute__((address_space(3)))
typedef unsigned short bf16_t;
typedef short bf16x8 __attribute__((ext_vector_type(8)));
typedef float f32x4 __attribute__((ext_vector_type(4)));
typedef unsigned u32x4 __attribute__((ext_vector_type(4)));
constexpr int BM = 256, BK = 64, HALF = 128, HTB = HALF * BK * 2  , STAGE_BYTES = 8 * HTB, NXCD = 8, WGM = 8;

__host__ __device__ __forceinline__ int lds_byte(int r, int c) { const int st = (r >> 4) * 2 + (c >> 5), rr = r & 15, cc = c & 31, ob = rr * 64 + cc * 2; return st * 1024 + (ob ^ (((ob >> 9) & 1) << 5)); }
__host__ __device__ __forceinline__ void stage_rc(int b, int& R, int& C) { const int st = b / 1024, sb = b % 1024, swz = sb ^ (((sb >> 9) & 1) << 5); R = (st >> 1) * 16 + swz / 64; C = (st & 1) * 32 + (swz % 64) / 2; }
__host__ __device__ __forceinline__ int perm32(int rho) { const int n = rho >> 4, i = rho & 15; return 8 * (i >> 2) + 4 * n + (i & 3); }

struct Unit { int pm, pn; };
struct Gemm { const bf16_t* A; const bf16_t* Bt; int M, N, K; };

struct StaticOrder {
    int nM, nN, nwg, G, c;
    __host__ __device__ void init(int M, int N, int G_, int c_) { nM = M / BM; nN = N / BM; nwg = nM * nN; G = G_; c = c_; }
    __host__ __device__ bool next(int i, Unit& u) const {
        const long L = (long)i * G + c; if (L >= nwg) return false;
        int wgid = (int)L; { const int q = nwg / NXCD, r = nwg % NXCD, xcd = wgid % NXCD, off = wgid / NXCD; wgid = (xcd < r ? xcd * (q + 1) : r * (q + 1) + (xcd - r) * q) + off; }
        const int nig = WGM * nN, gid = wgid / nig, fm = gid * WGM, gsz = (nM - fm) < WGM ? (nM - fm) : WGM;
        u.pm = fm + ((wgid % nig) % gsz); u.pn = (wgid % nig) / gsz; return true;
    }
    __device__ __forceinline__ void a_ready(const Unit&) const {}
    __device__ __forceinline__ void done(const Unit&) const {}
};

__device__ __forceinline__ unsigned cvt_pk_bf16(float lo, float hi) { unsigned r; asm volatile("v_cvt_pk_bf16_f32 %0, %1, %2" : "=v"(r) : "v"(lo), "v"(hi)); return r; }
__device__ __forceinline__ u32x4 pack8(f32x4 a, f32x4 b) { u32x4 w; w.x = cvt_pk_bf16(a[0], a[1]); w.y = cvt_pk_bf16(a[2], a[3]); w.z = cvt_pk_bf16(b[0], b[1]); w.w = cvt_pk_bf16(b[2], b[3]); return w; }
__device__ __forceinline__ float sigm_exp2(float t) { return __builtin_amdgcn_rcpf(1.0f + __builtin_amdgcn_exp2f(t)); }
__device__ __forceinline__ float silu_f(float x) { return x * sigm_exp2(-1.4426950408889634f * x); }
__device__ __forceinline__ float gelu_f(float x) { const float u = x * (1.0f + 0.044715f * x * x); return x * sigm_exp2(-2.302208198f * u); }

constexpr float QSCALE = 0.125f * 1.4426950408889634f;

struct EpiQKV {
    static constexpr bool PERM = true, AFTER_DRAIN = false;
    bf16_t* O; const float* bias; const float* cosT; const float* sinT;
    __device__ __forceinline__ void operator()(const f32x4 (&acc)[2][2][4][2], const Unit& u, int wr, int wc, int fr, int fq) const {
        const int row0 = u.pm * BM + wr * 64 + fr, colw = wc * 32 + 8 * fq, pn = u.pn, d0 = 16 * (wc & 1) + 4 * fq;
        f32x4 bv[2][2];
#pragma unroll
        for (int bj = 0; bj < 2; ++bj)
#pragma unroll
            for (int n = 0; n < 2; ++n) bv[bj][n] = *(const f32x4*)(bias + pn * BM + bj * HALF + colw + 4 * n);
        const float sc = pn < 4 ? QSCALE : 1.0f;
#pragma unroll
        for (int ai = 0; ai < 2; ++ai)
#pragma unroll
            for (int m = 0; m < 4; ++m) {
                const int row = row0 + ai * HALF + m * 16, pos = row & 4095;
                f32x4 cs = (f32x4){1.f, 1.f, 1.f, 1.f}, sn = (f32x4){0.f, 0.f, 0.f, 0.f};
                if (pn < 5) { cs = *(const f32x4*)(cosT + pos * 32 + d0); sn = *(const f32x4*)(sinT + pos * 32 + d0); }
                bf16_t* rowp = O + (size_t)row * 1536 + pn * BM + colw;
#pragma unroll
                for (int bj = 0; bj < 2; ++bj) {
                    const f32x4 v0 = acc[ai][bj][m][0] + bv[bj][0], v1 = acc[ai][bj][m][1] + bv[bj][1];
                    const f32x4 o0 = (v0 * cs - v1 * sn) * sc, o1 = (v1 * cs + v0 * sn) * sc;
                    *(u32x4*)(rowp + bj * HALF) = pack8(o0, o1);
                }
            }
    }
};
struct EpiSwiGLU {
    static constexpr bool PERM = true, AFTER_DRAIN = false;
    bf16_t* O;
    __device__ __forceinline__ void operator()(const f32x4 (&acc)[2][2][4][2], const Unit& u, int wr, int wc, int fr, int fq) const {
        const int row0 = u.pm * BM + wr * 64 + fr, col = u.pn * HALF + wc * 32 + 8 * fq;
#pragma unroll
        for (int ai = 0; ai < 2; ++ai)
#pragma unroll
            for (int m = 0; m < 4; ++m) {
                const int row = row0 + ai * HALF + m * 16;
                f32x4 h0, h1;
#pragma unroll
                for (int i = 0; i < 4; ++i) { h0[i] = silu_f(acc[ai][0][m][0][i]) * acc[ai][1][m][0][i]; h1[i] = silu_f(acc[ai][0][m][1][i]) * acc[ai][1][m][1][i]; }
                *(u32x4*)(O + (size_t)row * 2816 + col) = pack8(h0, h1);
            }
    }
};
struct EpiGelu {
    static constexpr bool PERM = true, AFTER_DRAIN = false;
    bf16_t* O; float* stats;
    __device__ __forceinline__ void operator()(const f32x4 (&acc)[2][2][4][2], const Unit& u, int wr, int wc, int fr, int fq) const {
        const int row0 = u.pm * BM + wr * 64 + fr, col = u.pn * BM + wc * 32 + 8 * fq, pn = u.pn;
#pragma unroll
        for (int ai = 0; ai < 2; ++ai)
#pragma unroll
            for (int m = 0; m < 4; ++m) {
                const int row = row0 + ai * HALF + m * 16;
                float s = 0.f, ss = 0.f;
#pragma unroll
                for (int bj = 0; bj < 2; ++bj) {
                    f32x4 z0, z1;
#pragma unroll
                    for (int i = 0; i < 4; ++i) { z0[i] = gelu_f(acc[ai][bj][m][0][i]); z1[i] = gelu_f(acc[ai][bj][m][1][i]); }
                    s += (z0[0] + z0[1]) + (z0[2] + z0[3]) + (z1[0] + z1[1]) + (z1[2] + z1[3]);
                    ss += (z0[0] * z0[0] + z0[1] * z0[1]) + (z0[2] * z0[2] + z0[3] * z0[3]) + (z1[0] * z1[0] + z1[1] * z1[1]) + (z1[2] * z1[2] + z1[3] * z1[3]);
                    *(u32x4*)(O + (size_t)row * 2048 + col + bj * HALF) = pack8(z0, z1);
                }
                if (pn >= 4) {
                    s += __shfl_xor(s, 16); s += __shfl_xor(s, 32); ss += __shfl_xor(ss, 16); ss += __shfl_xor(ss, 32);
                    if (fq == 0) { float* p = stats + ((size_t)row * 16 + (pn - 4) * 4 + wc) * 2; p[0] = s; p[1] = ss; }
                }
            }
    }
};
struct EpiF32 {
    static constexpr bool PERM = false, AFTER_DRAIN = false;
    float* out; int ldc; const float* bias;
    __device__ __forceinline__ void operator()(const f32x4 (&acc)[2][2][4][2], const Unit& u, int wr, int wc, int fr, int fq) const {
        const int row0 = u.pm * BM + wr * 64 + fr, col0 = u.pn * BM + wc * 32 + 4 * fq;
        f32x4 bv[2][2];
#pragma unroll
        for (int bj = 0; bj < 2; ++bj)
#pragma unroll
            for (int n = 0; n < 2; ++n) bv[bj][n] = bias ? *(const f32x4*)(bias + col0 + bj * HALF + n * 16) : (f32x4){0.f, 0.f, 0.f, 0.f};
#pragma unroll
        for (int ai = 0; ai < 2; ++ai)
#pragma unroll
            for (int m = 0; m < 4; ++m) {
                float* rowp = out + (size_t)(row0 + ai * HALF + m * 16) * ldc + col0;
#pragma unroll
                for (int bj = 0; bj < 2; ++bj)
#pragma unroll
                    for (int n = 0; n < 2; ++n) *(f32x4*)(rowp + bj * HALF + n * 16) = acc[ai][bj][m][n] + bv[bj][n];
            }
    }
};

template <class Epi, class Sched, bool ALIGN_EPI = false, bool SP2 = false>
__device__ __forceinline__ void gemm_phase(PG8_LAS unsigned char* lds, const Gemm g, const Sched& S, const Epi& E) {
    const int tid = threadIdx.x, wid = __builtin_amdgcn_readfirstlane(tid >> 6), lane = tid & 63, wr = wid >> 2, wc = wid & 3, fr = lane & 15, fq = lane >> 4;
    const int K = g.K, nt = K / BK;
    unsigned voffA[2], voffB[2];
#pragma unroll
    for (int i = 0; i < 2; ++i) { int R, C; stage_rc(tid * 16 + i * 8192, R, C); const int Rb = Epi::PERM ? ((R & ~31) + perm32(R & 31)) : R;
        voffA[i] = (unsigned)(R * K + C) * 2u; voffB[i] = (unsigned)(Rb * K + C) * 2u; }
    const size_t kstep = (size_t)(BK * 2);
    const size_t hstep = (size_t)HALF * K * 2;
    const size_t tstep = 2 * hstep;
    const unsigned ldsw = (unsigned)wid * 1024u;
    const int aoff = lds_byte(wr * 64 + fr, fq * 8), boff = lds_byte(wc * 32 + fr, fq * 8);
#define PG8_SA(b, h) (((b) * 2 + (h)) * HTB)
#define PG8_SB(b, h) ((4 + (b) * 2 + (h)) * HTB)
#define PG8_STAGE(bufoff, gbase, voff) do { _Pragma("unroll") for (int _i = 0; _i < 2; ++_i) \
        __builtin_amdgcn_global_load_lds((const unsigned*)((const char*)(gbase) + (voff)[_i]), (PG8_LAS unsigned*)(lds + (bufoff) + ldsw + _i * 8192), 16, 0, 0); } while (0)
#define PG8_LDA(dst, b, h) do { _Pragma("unroll") for (int m = 0; m < 4; ++m) _Pragma("unroll") for (int k = 0; k < 2; ++k) dst[m][k] = *(const PG8_LAS bf16x8*)(lds + PG8_SA(b, h) + aoff + m * 2048 + k * 1024); } while (0)
#define PG8_LDB(dst, b, h) do { _Pragma("unroll") for (int n = 0; n < 2; ++n) _Pragma("unroll") for (int k = 0; k < 2; ++k) dst[n][k] = *(const PG8_LAS bf16x8*)(lds + PG8_SB(b, h) + boff + n * 2048 + k * 1024); } while (0)
#define PG8_MMA(ai, bj, At, Bt) do { __builtin_amdgcn_s_setprio(1); _Pragma("unroll") for (int m = 0; m < 4; ++m) _Pragma("unroll") for (int n = 0; n < 2; ++n) _Pragma("unroll") for (int k = 0; k < 2; ++k) \
        acc[ai][bj][m][n] = __builtin_amdgcn_mfma_f32_16x16x32_bf16(Bt[n][k], At[m][k], acc[ai][bj][m][n], 0, 0, 0); __builtin_amdgcn_s_setprio(0); } while (0)
#define PG8_WAIT_V(n) asm volatile("s_waitcnt vmcnt(" #n ")" ::: "memory")
#define PG8_WAIT_L(n) asm volatile("s_waitcnt lgkmcnt(" #n ")" ::: "memory")
#define PG8_BAR __builtin_amdgcn_s_barrier()
#define PG8_SCHED __builtin_amdgcn_sched_barrier(0)
    Unit cur, nxt; int ui = 0;
    if (!S.next(0, cur)) return;
    f32x4 acc[2][2][4][2];
#pragma unroll
    for (int a = 0; a < 2; ++a)
#pragma unroll
        for (int b = 0; b < 2; ++b)
#pragma unroll
            for (int m = 0; m < 4; ++m)
#pragma unroll
                for (int n = 0; n < 2; ++n) acc[a][b][m][n] = (f32x4){0.f, 0.f, 0.f, 0.f};
    bf16x8 At[4][2], B0[2][2], B1[2][2];
    const char* cA = (const char*)g.A + (size_t)cur.pm * tstep; const char* cB = (const char*)g.Bt + (size_t)cur.pn * tstep;
    S.a_ready(cur);
    if constexpr (SP2) {
        PG8_STAGE(PG8_SB(0, 0), cB, voffB); PG8_STAGE(PG8_SB(0, 1), cB + hstep, voffB); PG8_STAGE(PG8_SA(0, 0), cA, voffA); PG8_STAGE(PG8_SA(0, 1), cA + hstep, voffA);
        if (wr == 1) PG8_BAR;
        PG8_WAIT_V(2); PG8_BAR;
        PG8_STAGE(PG8_SB(1, 0), cB + kstep, voffB); PG8_STAGE(PG8_SA(1, 0), cA + kstep, voffA); PG8_STAGE(PG8_SB(1, 1), cB + hstep + kstep, voffB);
        PG8_WAIT_V(6); PG8_BAR;
    } else {
        PG8_STAGE(PG8_SB(0, 0), cB, voffB); PG8_STAGE(PG8_SA(0, 0), cA, voffA); PG8_STAGE(PG8_SB(0, 1), cB + hstep, voffB); PG8_STAGE(PG8_SA(0, 1), cA + hstep, voffA);
        if (wr == 1) PG8_BAR;
        PG8_WAIT_V(4); PG8_BAR;
        PG8_STAGE(PG8_SB(1, 0), cB + kstep, voffB); PG8_STAGE(PG8_SA(1, 0), cA + kstep, voffA); PG8_STAGE(PG8_SB(1, 1), cB + hstep + kstep, voffB);
        PG8_WAIT_V(6); PG8_BAR;
    }
    for (;;) {
        const bool has_next = S.next(ui + 1, nxt);
        const char* nA = has_next ? (const char*)g.A + (size_t)nxt.pm * tstep : cA; const char* nB = has_next ? (const char*)g.Bt + (size_t)nxt.pn * tstep : cB;
        for (int t = 0; t < nt; t += 2) {
            const bool last = (t == nt - 2);
            const char* a1 = cA + (size_t)(t + 1) * kstep;
            const char* a2 = last ? nA : cA + (size_t)(t + 2) * kstep; const char* b2 = last ? nB : cB + (size_t)(t + 2) * kstep;
            const char* a3 = a2 + kstep; const char* b3 = b2 + kstep;
            if (last && has_next) S.a_ready(nxt);
            if constexpr (SP2) {
            PG8_LDB(B0, 0, 0); PG8_LDB(B1, 0, 1); PG8_SCHED; PG8_LDA(At, 0, 0); PG8_STAGE(PG8_SA(1, 1), a1 + hstep, voffA);
            PG8_WAIT_V(8); PG8_WAIT_L(0); PG8_BAR; PG8_MMA(0, 0, At, B0); PG8_MMA(0, 1, At, B1); PG8_BAR; PG8_SCHED;
            PG8_LDA(At, 0, 1); PG8_STAGE(PG8_SB(0, 0), b2, voffB); PG8_STAGE(PG8_SB(0, 1), b2 + hstep, voffB); PG8_STAGE(PG8_SA(0, 0), a2, voffA);
            PG8_WAIT_V(8); PG8_WAIT_L(0); PG8_BAR; PG8_MMA(1, 0, At, B0); PG8_MMA(1, 1, At, B1); PG8_BAR; PG8_SCHED;
            PG8_LDB(B0, 1, 0); PG8_LDB(B1, 1, 1); PG8_SCHED; PG8_LDA(At, 1, 0); PG8_STAGE(PG8_SA(0, 1), a2 + hstep, voffA);
            PG8_WAIT_V(8); PG8_WAIT_L(0); PG8_BAR; PG8_MMA(0, 0, At, B0); PG8_MMA(0, 1, At, B1); PG8_BAR; PG8_SCHED;
            PG8_LDA(At, 1, 1); PG8_STAGE(PG8_SB(1, 0), b3, voffB); PG8_STAGE(PG8_SB(1, 1), b3 + hstep, voffB); PG8_STAGE(PG8_SA(1, 0), a3, voffA);
            PG8_WAIT_V(8); PG8_WAIT_L(0); PG8_BAR; PG8_MMA(1, 0, At, B0); PG8_MMA(1, 1, At, B1); PG8_BAR; PG8_SCHED;
            } else {
            PG8_LDB(B0, 0, 0); PG8_SCHED; PG8_LDA(At, 0, 0); PG8_STAGE(PG8_SA(1, 1), a1 + hstep, voffA);
            PG8_WAIT_L(8); PG8_BAR; PG8_WAIT_L(0); PG8_MMA(0, 0, At, B0); PG8_BAR; PG8_SCHED;
            PG8_LDB(B1, 0, 1); PG8_STAGE(PG8_SB(0, 0), b2, voffB);
            PG8_BAR; PG8_WAIT_L(0); PG8_MMA(0, 1, At, B1); PG8_BAR;
            PG8_LDA(At, 0, 1); PG8_STAGE(PG8_SA(0, 0), a2, voffA);
            PG8_BAR; PG8_WAIT_L(0); PG8_MMA(1, 0, At, B0); PG8_BAR; PG8_SCHED;
            PG8_STAGE(PG8_SB(0, 1), b2 + hstep, voffB);
            PG8_WAIT_V(6); PG8_BAR; PG8_MMA(1, 1, At, B1); PG8_BAR;
            PG8_LDB(B0, 1, 0); PG8_SCHED; PG8_LDA(At, 1, 0); PG8_STAGE(PG8_SA(0, 1), a2 + hstep, voffA);
            PG8_WAIT_L(8); PG8_BAR; PG8_WAIT_L(0); PG8_MMA(0, 0, At, B0); PG8_BAR; PG8_SCHED;
            PG8_LDB(B1, 1, 1); PG8_STAGE(PG8_SB(1, 0), b3, voffB);
            PG8_BAR; PG8_WAIT_L(0); PG8_MMA(0, 1, At, B1); PG8_BAR;
            PG8_LDA(At, 1, 1); PG8_STAGE(PG8_SA(1, 0), a3, voffA);
            PG8_BAR; PG8_WAIT_L(0); PG8_MMA(1, 0, At, B0); PG8_BAR; PG8_SCHED;
            PG8_STAGE(PG8_SB(1, 1), b3 + hstep, voffB);
            PG8_WAIT_V(6); PG8_BAR; PG8_MMA(1, 1, At, B1); PG8_BAR;
            }
        }
        if constexpr (ALIGN_EPI) { if (wr == 0) PG8_BAR; }
        if constexpr (!Epi::AFTER_DRAIN) { E(acc, cur, wr, wc, fr, fq); S.done(cur); }
        if (!has_next) break;
#pragma unroll
        for (int a = 0; a < 2; ++a)
#pragma unroll
            for (int b = 0; b < 2; ++b)
#pragma unroll
                for (int m = 0; m < 4; ++m)
#pragma unroll
                    for (int n = 0; n < 2; ++n) acc[a][b][m][n] = (f32x4){0.f, 0.f, 0.f, 0.f};
        cur = nxt; cA = nA; cB = nB; ++ui;
        if constexpr (ALIGN_EPI) { if (wr == 1) PG8_BAR; }
    }
    PG8_WAIT_V(0);
    if constexpr (!ALIGN_EPI) { if (wr == 0) PG8_BAR; }
    PG8_BAR;
    if constexpr (Epi::AFTER_DRAIN) { E.fused(acc, cur, wr, wc, fr, fq, lds, wid, lane); S.done(cur); }
#undef PG8_SA
#undef PG8_SB
#undef PG8_STAGE
#undef PG8_LDA
#undef PG8_LDB
#undef PG8_MMA
#undef PG8_WAIT_V
#undef PG8_WAIT_L
#undef PG8_BAR
#undef PG8_SCHED
}
}

#ifndef PG8_SP2
#define PG8_SP2 true
#endif
#ifndef PG8_ALIGN
#define PG8_ALIGN true
#endif
#ifndef MK_SPLIT
#define MK_SPLIT 0
#endif

constexpr int NWAVES = 8;
constexpr int BATCH = 8, SEQ = 4096, D = 1024, M = BATCH * SEQ;
constexpr int NQKV = 1536, DFF = 2816, NGU = 2 * DFF, NZ = 2048;
constexpr float EPS = 1e-6f;
constexpr float LOG2E = 1.4426950408889634f;

constexpr size_t MiB = 1u << 20;
constexpr size_t WS_WQKV = 2 * MiB;
constexpr size_t WS_WO = 5 * MiB;
constexpr size_t WS_WIN = 7 * MiB;
constexpr size_t WS_WOUT = 11 * MiB;
constexpr size_t WS_WGU0 = 13 * MiB;
constexpr size_t WS_WGU1 = 24 * MiB;
constexpr size_t WS_WDN0 = 35 * MiB;
constexpr size_t WS_WDN1 = 41 * MiB;
constexpr size_t WS_WSB = 47 * MiB;
constexpr size_t WS_COS = 48 * MiB;
constexpr size_t WS_SIN = 49 * MiB;
constexpr size_t WS_BQKV = 50 * MiB;
constexpr size_t WS_STATS = 52 * MiB;
constexpr size_t WS_XN = 64 * MiB;
constexpr size_t WS_R1 = 128 * MiB;
constexpr size_t WS_QKV = WS_R1, WS_O = WS_R1 + 96 * MiB, WS_Z = WS_R1, WS_Y = WS_R1 + 128 * MiB, WS_H = WS_R1;
constexpr size_t WS_MO = 320 * MiB;
constexpr size_t WS_END = 448 * MiB;

constexpr int RING_BYTES = 131072;
constexpr int LDS_BYTES = 147456;

#define LAS __attribute__((address_space(3)))
typedef unsigned short bf16;
typedef unsigned v4u __attribute__((ext_vector_type(4)));
typedef unsigned v2u __attribute__((ext_vector_type(2)));
typedef float f32x4 __attribute__((ext_vector_type(4)));
typedef float f32x16 __attribute__((ext_vector_type(16)));
typedef short bf16x8 __attribute__((ext_vector_type(8)));
typedef short v4i16_t __attribute__((ext_vector_type(4)));
#define LDS_WAIT() asm volatile("s_waitcnt lgkmcnt(0)" ::: "memory")
__device__ __forceinline__ unsigned f2bf(float f) { unsigned u = __builtin_bit_cast(unsigned, f); return (u + 0x7fffu + ((u >> 16) & 1u)) >> 16; }
__device__ __forceinline__ unsigned pk2(float lo, float hi) { return f2bf(lo) | (f2bf(hi) << 16); }
__device__ __forceinline__ float bf_lo(unsigned w) { return __builtin_bit_cast(float, w << 16); }
__device__ __forceinline__ float bf_hi(unsigned w) { return __builtin_bit_cast(float, w & 0xffff0000u); }
__device__ __forceinline__ float wave_sum(float v) {
#pragma unroll
    for (int o = 1; o < 64; o <<= 1) v += __shfl_xor(v, o);
    return v;
}
__device__ __forceinline__ bf16x8 tr_pair(const LAS unsigned char* p0, const LAS unsigned char* p1) {
    const v4i16_t a = __builtin_amdgcn_ds_read_tr16_b64_v4i16((LAS v4i16_t*)p0), b = __builtin_amdgcn_ds_read_tr16_b64_v4i16((LAS v4i16_t*)p1);
    return (bf16x8){a[0], a[1], a[2], a[3], b[0], b[1], b[2], b[3]};
}

__device__ __forceinline__ int dst_row(int mode, int n) {
    if (mode == 1) { if (n >= 1280) return n; const int h = n >> 6, d = n & 63, J = (d & 31) >> 2, e = (d & 3) + ((d >> 5) << 2); return h * 64 + 8 * J + e; }
    if (mode == 2) { const int up = n >= DFF ? 1 : 0, c = n - up * DFF; return (c >> 7) * 256 + up * 128 + (c & 127); }
    return n;
}
__device__ __forceinline__ void p0_transpose_item(const float* W, int K, int N, bf16* WT, int mode, LAS float* scr, int item, int lane) {
    const int nblk = N / 32, kb = item / nblk, nb = item % nblk, k0 = 64 * kb, n0 = 32 * nb;
#pragma unroll 8
    for (int i = 0; i < 32; ++i) { const int kk = 2 * i + (lane >> 5); scr[kk * 33 + (lane & 31)] = W[(size_t)(k0 + kk) * N + n0 + (lane & 31)]; }
    LDS_WAIT(); asm volatile("" ::: "memory");
    const int c = lane & 7;
#pragma unroll
    for (int j = 0; j < 4; ++j) { const int n = (lane >> 3) + 8 * j; const LAS float* s = scr + (8 * c) * 33 + n;
        v4u o; o.x = pk2(s[0 * 33], s[1 * 33]); o.y = pk2(s[2 * 33], s[3 * 33]); o.z = pk2(s[4 * 33], s[5 * 33]); o.w = pk2(s[6 * 33], s[7 * 33]);
        *(v4u*)(WT + (size_t)dst_row(mode, n0 + n) * K + k0 + 8 * c) = o; }
    LDS_WAIT(); asm volatile("" ::: "memory");
}
__device__ __forceinline__ void rms_row_to_bf16(const float* xrow, const float* g, bf16* orow, int lane) {
    const f32x4* xr = (const f32x4*)xrow + lane; const f32x4* gr = (const f32x4*)g + lane;
    f32x4 v[4]; float s = 0.f;
#pragma unroll
    for (int j = 0; j < 4; ++j) { v[j] = xr[64 * j]; s += (v[j].x * v[j].x + v[j].y * v[j].y) + (v[j].z * v[j].z + v[j].w * v[j].w); }
    const float rs = 1.0f / sqrtf(wave_sum(s) * (1.f / D) + EPS);
    unsigned long long* o8 = (unsigned long long*)orow + lane;
#pragma unroll
    for (int j = 0; j < 4; ++j) { const f32x4 gg = gr[64 * j]; const f32x4 y = v[j] * rs * gg; o8[64 * j] = (unsigned long long)pk2(y.x, y.y) | ((unsigned long long)pk2(y.z, y.w) << 32); }
}
__device__ __forceinline__ void norm_res_norm_rows(const float* x_in, const float* mo, const float* g_post, float* x_out, const float* g_pre, bf16* xn, int gw, int NGW, int lane) {
    for (int m = gw; m < M; m += NGW) {
        const f32x4* mr = (const f32x4*)(mo + (size_t)m * D) + lane; const f32x4* xr = (const f32x4*)(x_in + (size_t)m * D) + lane;
        f32x4 v[4], xv[4]; float s = 0.f;
#pragma unroll
        for (int j = 0; j < 4; ++j) { v[j] = mr[64 * j]; xv[j] = xr[64 * j]; s += (v[j].x * v[j].x + v[j].y * v[j].y) + (v[j].z * v[j].z + v[j].w * v[j].w); }
        const float rs = 1.0f / sqrtf(wave_sum(s) * (1.f / D) + EPS);
        float s2 = 0.f; f32x4* xo = (f32x4*)(x_out + (size_t)m * D) + lane;
#pragma unroll
        for (int j = 0; j < 4; ++j) { const f32x4 gg = ((const f32x4*)g_post + lane)[64 * j]; xv[j] = xv[j] + v[j] * rs * gg; xo[64 * j] = xv[j];
            s2 += (xv[j].x * xv[j].x + xv[j].y * xv[j].y) + (xv[j].z * xv[j].z + xv[j].w * xv[j].w); }
        if (xn) {
            const float rs2 = 1.0f / sqrtf(wave_sum(s2) * (1.f / D) + EPS);
            unsigned long long* o8 = (unsigned long long*)(xn + (size_t)m * D) + lane;
#pragma unroll
            for (int j = 0; j < 4; ++j) { const f32x4 gg = ((const f32x4*)g_pre + lane)[64 * j]; const f32x4 y = xv[j] * rs2 * gg; o8[64 * j] = (unsigned long long)pk2(y.x, y.y) | ((unsigned long long)pk2(y.z, y.w) << 32); }
        }
    }
}

constexpr int ATT_RS = 144, ATT_K = 0, ATT_V = 256 * ATT_RS;
__device__ __forceinline__ void attn_phase(LAS unsigned char* lds, const bf16* QKV, bf16* O, const float* sinks, int vcu, int G) {
    const int tid = threadIdx.x, lane = tid & 63, r32 = lane & 31, hi = lane >> 5; const int wid = __builtin_amdgcn_readfirstlane(tid >> 6);
    const int sig = (r32 & ~12) | ((r32 & 4) << 1) | ((r32 & 8) >> 1);
    for (int unit = vcu; unit < BATCH * 32 * 4; unit += G) {
        const int kvh = unit & 3, nb = (unit >> 2) & 31, b = unit >> 7;
        __syncthreads();
        const long tok0 = (long)b * SEQ + (nb - 1) * 128;
#pragma unroll
        for (int i = 0; i < 4; ++i) {
            const int c = tid + 512 * i, row = c >> 3, ch = c & 7;
            v4u kq = (v4u){0u, 0u, 0u, 0u}, vq = (v4u){0u, 0u, 0u, 0u};
            if (nb > 0 || row >= 128) { const bf16* src = QKV + (tok0 + row) * NQKV + 1024 + kvh * 64 + ch * 8; kq = *(const v4u*)src; vq = *(const v4u*)(src + 256); }
            *(LAS v4u*)(lds + ATT_K + row * ATT_RS + ch * 16) = kq; *(LAS v4u*)(lds + ATT_V + row * ATT_RS + ch * 16) = vq;
        }
        __syncthreads();
        const int head = kvh * 4 + (wid >> 1);
        const float sink2 = sinks[head] * LOG2E;
        for (int sb = 0; sb < 2; ++sb) {
            const int s = 2 * (wid & 1) + sb;
            const long qtok = (long)b * SEQ + nb * 128 + 32 * s + r32;
            bf16x8 qf[4];
#pragma unroll
            for (int ds = 0; ds < 4; ++ds) qf[ds] = *(const bf16x8*)(QKV + qtok * NQKV + head * 64 + 16 * ds + 8 * hi);
            f32x16 S[5];
#pragma unroll
            for (int jt = 0; jt < 5; ++jt) {
                f32x16 a = {};
                const LAS unsigned char* kp = lds + ATT_K + (32 * (s + jt) + sig) * ATT_RS + 16 * hi;
#pragma unroll
                for (int ds = 0; ds < 4; ++ds) { const bf16x8 kf = *(const LAS bf16x8*)(kp + 32 * ds); a = __builtin_amdgcn_mfma_f32_32x32x16_bf16(kf, qf[ds], a, 0, 0, 0); }
                S[jt] = a;
            }
            const float NEG = -INFINITY;
#pragma unroll
            for (int r = 0; r < 16; ++r) { const int kt = 16 * (r >> 3) + 8 * hi + (r & 7); if (kt <= r32) S[0][r] = NEG; if (kt > r32) S[4][r] = NEG; }
            if (nb == 0) {
#pragma unroll
                for (int jt = 0; jt < 4; ++jt) if (jt < 4 - s) {
#pragma unroll
                    for (int r = 0; r < 16; ++r) S[jt][r] = NEG; }
            }
            float mx = sink2;
#pragma unroll
            for (int jt = 0; jt < 5; ++jt)
#pragma unroll
                for (int r = 0; r < 16; ++r) mx = fmaxf(mx, S[jt][r]);
            mx = fmaxf(mx, __shfl_xor(mx, 32));
            float sum = 0.f;
#pragma unroll
            for (int jt = 0; jt < 5; ++jt)
#pragma unroll
                for (int r = 0; r < 16; ++r) { const float p = __builtin_amdgcn_exp2f(S[jt][r] - mx); S[jt][r] = p; sum += p; }
            sum += __shfl_xor(sum, 32); sum += __builtin_amdgcn_exp2f(sink2 - mx);
            f32x16 o0 = {}, o1 = {};
            const int blk = (lane >> 4) & 1, qq = (lane & 15) >> 2, p4 = lane & 3;
            const LAS unsigned char* vp = lds + ATT_V + (32 * s + 8 * hi + qq) * ATT_RS + 32 * blk + 8 * p4;
#pragma unroll
            for (int ks = 0; ks < 10; ++ks) {
                const int jt = ks >> 1, h8 = (ks & 1) * 8;
                v4u pw; pw.x = pg8::cvt_pk_bf16(S[jt][h8 + 0], S[jt][h8 + 1]); pw.y = pg8::cvt_pk_bf16(S[jt][h8 + 2], S[jt][h8 + 3]); pw.z = pg8::cvt_pk_bf16(S[jt][h8 + 4], S[jt][h8 + 5]); pw.w = pg8::cvt_pk_bf16(S[jt][h8 + 6], S[jt][h8 + 7]);
                const bf16x8 pf = __builtin_bit_cast(bf16x8, pw);
                const LAS unsigned char* vk = vp + 16 * ks * ATT_RS;
                const bf16x8 va0 = tr_pair(vk, vk + 4 * ATT_RS), va1 = tr_pair(vk + 64, vk + 64 + 4 * ATT_RS);
                o0 = __builtin_amdgcn_mfma_f32_32x32x16_bf16(va0, pf, o0, 0, 0, 0);
                o1 = __builtin_amdgcn_mfma_f32_32x32x16_bf16(va1, pf, o1, 0, 0, 0);
            }
            const float inv = 1.0f / sum;
            bf16* op = O + qtok * D + head * 64 + 4 * hi;
#pragma unroll
            for (int rg = 0; rg < 4; ++rg) {
                v2u w0, w1;
                w0.x = pg8::cvt_pk_bf16(o0[4 * rg] * inv, o0[4 * rg + 1] * inv); w0.y = pg8::cvt_pk_bf16(o0[4 * rg + 2] * inv, o0[4 * rg + 3] * inv);
                w1.x = pg8::cvt_pk_bf16(o1[4 * rg] * inv, o1[4 * rg + 1] * inv); w1.y = pg8::cvt_pk_bf16(o1[4 * rg + 2] * inv, o1[4 * rg + 3] * inv);
                *(v2u*)(op + 8 * rg) = w0; *(v2u*)(op + 32 + 8 * rg) = w1;
            }
        }
    }
    __syncthreads();
}

constexpr int SG_RS = 272, SG_TV = 0, SG_TS = 128 * SG_RS, SG_ST = 2 * 128 * SG_RS;
__device__ __forceinline__ void sgu_phase(LAS unsigned char* lds, const bf16* Z, bf16* Y, const float* stats, const float* lng, const float* lnb, const bf16* wsb, const float* bsp, int vcu, int G) {
    const int tid = threadIdx.x, lane = tid & 63, r32 = lane & 31, hi = lane >> 5; const int wid = __builtin_amdgcn_readfirstlane(tid >> 6);
    LAS float* st = (LAS float*)(lds + SG_ST);
    for (int unit = vcu; unit < 256 * 8; unit += G) {
        const int g = unit & 7, c = unit >> 3; const long tok0 = (long)c * 128;
        __syncthreads();
        if (tid < 128) {
            const f32x4* sp = (const f32x4*)(stats + (tok0 + tid) * 32); float s = 0.f, ss = 0.f;
#pragma unroll
            for (int k = 0; k < 8; ++k) { const f32x4 q = sp[k]; s += q.x + q.z; ss += q.y + q.w; }
            const float mu = s * (1.f / 1024.f), var = ss * (1.f / 1024.f) - mu * mu;
            st[2 * tid] = mu; st[2 * tid + 1] = 1.0f / sqrtf(fmaxf(var, 0.f) + EPS);
        }
        __syncthreads();
#pragma unroll
        for (int i = 0; i < 4; ++i) {
            const int idx = tid + 512 * i, row = idx >> 4, ch = idx & 15;
            const v4u q = *(const v4u*)(Z + (tok0 + row) * NZ + 1024 + g * 128 + ch * 8);
            const float mu = st[2 * row], rs = st[2 * row + 1];
            const f32x4 g0 = *(const f32x4*)(lng + g * 128 + ch * 8), g1 = *(const f32x4*)(lng + g * 128 + ch * 8 + 4), b0 = *(const f32x4*)(lnb + g * 128 + ch * 8), b1 = *(const f32x4*)(lnb + g * 128 + ch * 8 + 4);
            v4u o;
            o.x = pk2((bf_lo(q.x) - mu) * rs * g0.x + b0.x, (bf_hi(q.x) - mu) * rs * g0.y + b0.y); o.y = pk2((bf_lo(q.y) - mu) * rs * g0.z + b0.z, (bf_hi(q.y) - mu) * rs * g0.w + b0.w);
            o.z = pk2((bf_lo(q.z) - mu) * rs * g1.x + b1.x, (bf_hi(q.z) - mu) * rs * g1.y + b1.y); o.w = pk2((bf_lo(q.w) - mu) * rs * g1.z + b1.z, (bf_hi(q.w) - mu) * rs * g1.w + b1.w);
            *(LAS v4u*)(lds + SG_TV + row * SG_RS + ch * 16) = o;
        }
        __syncthreads();
        {
            const int db = wid >> 1;
            const int blk = (lane >> 4) & 1, qq = (lane & 15) >> 2, p4 = lane & 3;
            const LAS unsigned char* vp = lds + SG_TV + (8 * hi + qq) * SG_RS + 64 * db + 32 * blk + 8 * p4;
#pragma unroll
            for (int ti = 0; ti < 2; ++ti) {
                const int tb = (wid & 1) ? (1 + ti) : (3 * ti);
                f32x16 a = {};
                const bf16* wrow = wsb + ((size_t)g * 128 + tb * 32 + r32) * 128 + 8 * hi;
                for (int ks = 0; ks < 2 * (tb + 1); ++ks) {
                    const bf16x8 wf = *(const bf16x8*)(wrow + 16 * ks);
                    const LAS unsigned char* vk = vp + 16 * ks * SG_RS;
                    const bf16x8 va = tr_pair(vk, vk + 4 * SG_RS);
                    a = __builtin_amdgcn_mfma_f32_32x32x16_bf16(va, wf, a, 0, 0, 0);
                }
                const float bs = bsp[g * 128 + tb * 32 + r32];
                LAS unsigned char* tp = lds + SG_TS + (tb * 32 + r32) * SG_RS + (db * 32 + 4 * hi) * 2;
#pragma unroll
                for (int rg = 0; rg < 4; ++rg) { v2u w; w.x = pg8::cvt_pk_bf16(a[4 * rg] + bs, a[4 * rg + 1] + bs); w.y = pg8::cvt_pk_bf16(a[4 * rg + 2] + bs, a[4 * rg + 3] + bs); *(LAS v2u*)(tp + 16 * rg) = w; }
            }
        }
        __syncthreads();
#pragma unroll
        for (int i = 0; i < 4; ++i) {
            const int idx = tid + 512 * i, row = idx >> 4, ch = idx & 15;
            const v4u mq = *(const LAS v4u*)(lds + SG_TS + row * SG_RS + ch * 16);
            const v4u uq = *(const v4u*)(Z + (tok0 + row) * NZ + g * 128 + ch * 8);
            v4u o;
            o.x = pk2(bf_lo(mq.x) * bf_lo(uq.x), bf_hi(mq.x) * bf_hi(uq.x)); o.y = pk2(bf_lo(mq.y) * bf_lo(uq.y), bf_hi(mq.y) * bf_hi(uq.y));
            o.z = pk2(bf_lo(mq.z) * bf_lo(uq.z), bf_hi(mq.z) * bf_hi(uq.z)); o.w = pk2(bf_lo(mq.w) * bf_lo(uq.w), bf_hi(mq.w) * bf_hi(uq.w));
            *(v4u*)(Y + (tok0 + row) * D + g * 128 + ch * 8) = o;
        }
    }
    __syncthreads();
}

struct Args { const float* in[18]; float* out; unsigned char* ws; int ph_lo, ph_hi; };
constexpr int N_PHASES = 15;

__global__ void __launch_bounds__(NWAVES * 64, 2) mega_fwd(Args args) {
    extern __shared__ __attribute__((aligned(16))) unsigned char lds_raw[];
    LAS unsigned char* lds = (LAS unsigned char*)lds_raw;
    cg::grid_group grid = cg::this_grid();
    const int tid = threadIdx.x, lane = tid & 63, wave = __builtin_amdgcn_readfirstlane(tid >> 6);
    const int G = gridDim.x, bx = blockIdx.x;
    const int vcu = (G % 8 == 0) ? (bx % 8) * (G / 8) + bx / 8 : bx;
    const int gw = vcu * NWAVES + wave, NGW = G * NWAVES;
    unsigned char* ws = args.ws;
    const float* x = args.in[0];
    const float *g_mix_pre = args.in[1], *g_mix_post = args.in[2], *g_ffn_pre = args.in[3], *g_ffn_post = args.in[4];
    const float *w_qkv = args.in[5], *b_qkv = args.in[6], *sinks = args.in[7], *w_o = args.in[8], *b_o = args.in[9];
    const float *w_in = args.in[10], *ln_g = args.in[11], *ln_b = args.in[12], *w_sp = args.in[13], *b_sp = args.in[14], *w_out = args.in[15];
    const float *w_gu = args.in[16], *w_dn = args.in[17];
    float* out = args.out;
    bf16 *Wqkv_t = (bf16*)(ws + WS_WQKV), *Wo_t = (bf16*)(ws + WS_WO), *Win_t = (bf16*)(ws + WS_WIN), *Wout_t = (bf16*)(ws + WS_WOUT);
    bf16 *Wgu0 = (bf16*)(ws + WS_WGU0), *Wgu1 = (bf16*)(ws + WS_WGU1), *Wdn0 = (bf16*)(ws + WS_WDN0), *Wdn1 = (bf16*)(ws + WS_WDN1), *wsb = (bf16*)(ws + WS_WSB);
    float *cosT = (float*)(ws + WS_COS), *sinT = (float*)(ws + WS_SIN), *bqkvP = (float*)(ws + WS_BQKV), *stats = (float*)(ws + WS_STATS), *MO = (float*)(ws + WS_MO);
    bf16 *XN = (bf16*)(ws + WS_XN), *QKV = (bf16*)(ws + WS_QKV), *OB = (bf16*)(ws + WS_O), *ZB = (bf16*)(ws + WS_Z), *YB = (bf16*)(ws + WS_Y), *HB = (bf16*)(ws + WS_H);

    const int lo = args.ph_lo, hi = args.ph_hi;
#define IN(k) (lo <= (k) && (k) < hi)
#define SEAM(k) do { if (IN(k) && IN((k) + 1)) grid.sync(); } while (0)

    if (IN(0)) {
        LAS float* scr = (LAS float*)(lds + wave * 16384);
        constexpr int I_QKV = 16 * 48, I_O = 16 * 32, I_IN = 16 * 64, I_OUT = 16 * 32, I_GU = 16 * 176, I_DN = 44 * 32;
        constexpr int NITEMS = I_QKV + I_O + I_IN + I_OUT + 2 * I_GU + 2 * I_DN;
        for (int it = gw; it < NITEMS; it += NGW) {
            int r = it;
            if (r < I_QKV) { p0_transpose_item(w_qkv, D, NQKV, Wqkv_t, 1, scr, r, lane); continue; } r -= I_QKV;
            if (r < I_O) { p0_transpose_item(w_o, D, D, Wo_t, 0, scr, r, lane); continue; } r -= I_O;
            if (r < I_IN) { p0_transpose_item(w_in, D, NZ, Win_t, 0, scr, r, lane); continue; } r -= I_IN;
            if (r < I_OUT) { p0_transpose_item(w_out, D, D, Wout_t, 0, scr, r, lane); continue; } r -= I_OUT;
            if (r < I_GU) { p0_transpose_item(w_gu, D, NGU, Wgu0, 2, scr, r, lane); continue; } r -= I_GU;
            if (r < I_GU) { p0_transpose_item(w_gu + (size_t)D * NGU, D, NGU, Wgu1, 2, scr, r, lane); continue; } r -= I_GU;
            if (r < I_DN) { p0_transpose_item(w_dn, DFF, D, Wdn0, 0, scr, r, lane); continue; } r -= I_DN;
            p0_transpose_item(w_dn + (size_t)DFF * D, DFF, D, Wdn1, 0, scr, r, lane);
        }
        const int gt = vcu * (NWAVES * 64) + tid, NGT = G * NWAVES * 64;
        for (int i = gt; i < 8 * 128 * 128; i += NGT) { const int s = i & 127, t = (i >> 7) & 127; wsb[i] = (bf16)f2bf(s <= t ? w_sp[i] : 0.f); }
        for (int i = gt; i < SEQ * 32; i += NGT) {
            const int pos = i >> 5, j = i & 31;
            const float inv_freq = exp2f(-(float)(2 * j) * (1.0f / 64.0f) * 13.287712379549449f);
            const float ang = (float)pos * inv_freq;
            const double a = (double)ang, k = rint(a * 0.15915494309189535), rr = a - k * 6.283185307179586;
            cosT[i] = cosf((float)rr); sinT[i] = sinf((float)rr);
        }
        for (int i = gt; i < NQKV; i += NGT) {
            int src = i;
            if (i < 1280) { const int h = i >> 6, p = i & 63, J = p >> 3, e = p & 7; src = h * 64 + (e < 4 ? 4 * J + e : 32 + 4 * J + (e - 4)); }
            bqkvP[i] = b_qkv[src];
        }
        for (int m = gw; m < M; m += NGW) rms_row_to_bf16(x + (size_t)m * D, g_mix_pre, XN + (size_t)m * D, lane);
    }
    SEAM(0);
    if (IN(1)) { pg8::Gemm g{XN, Wqkv_t, M, NQKV, D}; pg8::StaticOrder S; S.init(M, NQKV, G, bx); pg8::EpiQKV E{QKV, bqkvP, cosT, sinT};
        pg8::gemm_phase<pg8::EpiQKV, pg8::StaticOrder, PG8_ALIGN, PG8_SP2>(lds, g, S, E); }
    SEAM(1);
    if (IN(2)) attn_phase(lds, QKV, OB, sinks, vcu, G);
    SEAM(2);
    if (IN(3)) { pg8::Gemm g{OB, Wo_t, M, D, D}; pg8::StaticOrder S; S.init(M, D, G, bx); pg8::EpiF32 E{MO, D, b_o};
        pg8::gemm_phase<pg8::EpiF32, pg8::StaticOrder, PG8_ALIGN, PG8_SP2>(lds, g, S, E); }
    SEAM(3);
    if (IN(4)) norm_res_norm_rows(x, MO, g_mix_post, out, g_ffn_pre, XN, gw, NGW, lane);
    SEAM(4);
    if (IN(5)) { pg8::Gemm g{XN, Wgu0, M, NGU, D}; pg8::StaticOrder S; S.init(M, NGU, G, bx); pg8::EpiSwiGLU E{HB};
        pg8::gemm_phase<pg8::EpiSwiGLU, pg8::StaticOrder, PG8_ALIGN, PG8_SP2>(lds, g, S, E); }
    SEAM(5);
    if (IN(6)) { pg8::Gemm g{HB, Wdn0, M, D, DFF}; pg8::StaticOrder S; S.init(M, D, G, bx); pg8::EpiF32 E{MO, D, nullptr};
        pg8::gemm_phase<pg8::EpiF32, pg8::StaticOrder, PG8_ALIGN, PG8_SP2>(lds, g, S, E); }
    SEAM(6);
    if (IN(7)) norm_res_norm_rows(out, MO, g_ffn_post, out, g_mix_pre + D, XN, gw, NGW, lane);
    SEAM(7);
    if (IN(8)) { pg8::Gemm g{XN, Win_t, M, NZ, D}; pg8::StaticOrder S; S.init(M, NZ, G, bx); pg8::EpiGelu E{ZB, stats};
        pg8::gemm_phase<pg8::EpiGelu, pg8::StaticOrder, PG8_ALIGN, PG8_SP2>(lds, g, S, E); }
    SEAM(8);
    if (IN(9)) sgu_phase(lds, ZB, YB, stats, ln_g, ln_b, wsb, b_sp, vcu, G);
    SEAM(9);
    if (IN(10)) { pg8::Gemm g{YB, Wout_t, M, D, D}; pg8::StaticOrder S; S.init(M, D, G, bx); pg8::EpiF32 E{MO, D, nullptr};
        pg8::gemm_phase<pg8::EpiF32, pg8::StaticOrder, PG8_ALIGN, PG8_SP2>(lds, g, S, E); }
    SEAM(10);
    if (IN(11)) norm_res_norm_rows(out, MO, g_mix_post + D, out, g_ffn_pre + D, XN, gw, NGW, lane);
    SEAM(11);
    if (IN(12)) { pg8::Gemm g{XN, Wgu1, M, NGU, D}; pg8::StaticOrder S; S.init(M, NGU, G, bx); pg8::EpiSwiGLU E{HB};
        pg8::gemm_phase<pg8::EpiSwiGLU, pg8::StaticOrder, PG8_ALIGN, PG8_SP2>(lds, g, S, E); }
    SEAM(12);
    if (IN(13)) { pg8::Gemm g{HB, Wdn1, M, D, DFF}; pg8::StaticOrder S; S.init(M, D, G, bx); pg8::EpiF32 E{MO, D, nullptr};
        pg8::gemm_phase<pg8::EpiF32, pg8::StaticOrder, PG8_ALIGN, PG8_SP2>(lds, g, S, E); }
    SEAM(13);
    if (IN(14)) norm_res_norm_rows(out, MO, g_ffn_post + D, out, nullptr, nullptr, gw, NGW, lane);
#undef IN
#undef SEAM
}

extern "C" void kernel_launch(void* const* d_in, const int* in_sizes, int n_in, void* d_out, int out_size, void* d_ws, size_t ws_size, hipStream_t stream) {
    static int grid = 0;
    if (grid == 0) {
        if (n_in != 18 || in_sizes[0] != M * D || out_size != M * D || ws_size < WS_END) { fprintf(stderr, "kernel_launch: unexpected shapes (n_in %d, in0 %d, out %d, ws %zu); nothing launched\n", n_in, n_in > 0 ? in_sizes[0] : -1, out_size, ws_size); grid = -1; return; }
        int dev = 0, cus = 0, per_cu = 0;
        if (hipGetDevice(&dev) != hipSuccess || hipDeviceGetAttribute(&cus, hipDeviceAttributeMultiprocessorCount, dev) != hipSuccess) { grid = -1; return; }
        if (hipFuncSetAttribute((const void*)mega_fwd, hipFuncAttributeMaxDynamicSharedMemorySize, LDS_BYTES) != hipSuccess) { fprintf(stderr, "kernel_launch: hipFuncSetAttribute failed\n"); grid = -1; return; }
        if (hipOccupancyMaxActiveBlocksPerMultiprocessor(&per_cu, (const void*)mega_fwd, NWAVES * 64, LDS_BYTES) != hipSuccess || per_cu < 1) { fprintf(stderr, "kernel_launch: occupancy query gave %d\n", per_cu); (void)hipGetLastError(); per_cu = 1; }
        grid = cus * per_cu;
    }
    if (grid < 0) return;
    Args a{};
    for (int i = 0; i < 18; ++i) a.in[i] = (const float*)d_in[i];
    a.out = (float*)d_out; a.ws = (unsigned char*)d_ws;
#if MK_SPLIT
    for (int p = 0; p < N_PHASES; ++p) { a.ph_lo = p; a.ph_hi = p + 1; hipLaunchKernelGGL(mega_fwd, dim3(grid), dim3(NWAVES * 64), LDS_BYTES, stream, a); }
#else
    a.ph_lo = 0; a.ph_hi = N_PHASES;
    void* kargs[] = {&a};
    hipError_t e = hipLaunchCooperativeKernel((const void*)mega_fwd, dim3(grid), dim3(NWAVES * 64), kargs, LDS_BYTES, stream);
    if (e != hipSuccess) fprintf(stderr, "kernel_launch: cooperative launch failed: %s (grid %d)\n", hipGetErrorString(e), grid);
#endif
}
```

```cpp
#include <hip/hip_runtime.h>
#include <hip/hip_cooperative_groups.h>
#include <cstdio>
#include <cstdint>
namespace cg = cooperative_groups;
namespace pg8 {
#define PG8_LAS __attribute__((address_space(3)))
typedef unsigned short bf16_t;
typedef short bf16x8 __attribute__((ext_vector_type(8)));
typedef float f32x4 __attribute__((ext_vector_type(4)));
typedef unsigned u32x4 __attribute__((ext_vector_type(4)));
constexpr int BM = 256, BK = 64, HALF = 128, HTB = HALF * BK * 2  , STAGE_BYTES = 8 * HTB, NXCD = 8, WGM = 8;

__host__ __device__ __forceinline__ int lds_byte(int r, int c) { const int st = (r >> 4) * 2 + (c >> 5), rr = r & 15, cc = c & 31, ob = rr * 64 + cc * 2; return st * 1024 + (ob ^ (((ob >> 9) & 1) << 5)); }
__host__ __device__ __forceinline__ void stage_rc(int b, int& R, int& C) { const int st = b / 1024, sb = b % 1024, swz = sb ^ (((sb >> 9) & 1) << 5); R = (st >> 1) * 16 + swz / 64; C = (st & 1) * 32 + (swz % 64) / 2; }
__host__ __device__ __forceinline__ int perm32(int rho) { const int n = rho >> 4, i = rho & 15; return 8 * (i >> 2) + 4 * n + (i & 3); }

struct Unit { int pm, pn; };
struct Gemm { const bf16_t* A; const bf16_t* Bt; int M, N, K; };

struct StaticOrder {
    int nM, nN, nwg, G, c;
    __host__ __device__ void init(int M, int N, int G_, int c_) { nM = M / BM; nN = N / BM; nwg = nM * nN; G = G_; c = c_; }
    __host__ __device__ bool next(int i, Unit& u) const {
        const long L = (long)i * G + c; if (L >= nwg) return false;
        int wgid = (int)L; { const int q = nwg / NXCD, r = nwg % NXCD, xcd = wgid % NXCD, off = wgid / NXCD; wgid = (xcd < r ? xcd * (q + 1) : r * (q + 1) + (xcd - r) * q) + off; }
        const int nig = WGM * nN, gid = wgid / nig, fm = gid * WGM, gsz = (nM - fm) < WGM ? (nM - fm) : WGM;
        u.pm = fm + ((wgid % nig) % gsz); u.pn = (wgid % nig) / gsz; return true;
    }
    __device__ __forceinline__ void a_ready(const Unit&) const {}
    __device__ __forceinline__ void done(const Unit&) const {}
};

__device__ __forceinline__ unsigned cvt_pk_bf16(float lo, float hi) { unsigned r; asm volatile("v_cvt_pk_bf16_f32 %0, %1, %2" : "=v"(r) : "v"(lo), "v"(hi)); return r; }
__device__ __forceinline__ u32x4 pack8(f32x4 a, f32x4 b) { u32x4 w; w.x = cvt_pk_bf16(a[0], a[1]); w.y = cvt_pk_bf16(a[2], a[3]); w.z = cvt_pk_bf16(b[0], b[1]); w.w = cvt_pk_bf16(b[2], b[3]); return w; }
__device__ __forceinline__ float sigm_exp2(float t) { return __builtin_amdgcn_rcpf(1.0f + __builtin_amdgcn_exp2f(t)); }
__device__ __forceinline__ float silu_f(float x) { return x * sigm_exp2(-1.4426950408889634f * x); }
__device__ __forceinline__ float gelu_f(float x) { const float u = x * (1.0f + 0.044715f * x * x); return x * sigm_exp2(-2.302208198f * u); }

constexpr float QSCALE = 0.125f * 1.4426950408889634f;

struct EpiQKV {
    static constexpr bool PERM = true, AFTER_DRAIN = false;
    bf16_t* O; const float* bias; const float* cosT; const float* sinT;
    __device__ __forceinline__ void operator()(const f32x4 (&acc)[2][2][4][2], const Unit& u, int wr, int wc, int fr, int fq) const {
        const int row0 = u.pm * BM + wr * 64 + fr, colw = wc * 32 + 8 * fq, pn = u.pn, d0 = 16 * (wc & 1) + 4 * fq;
        f32x4 bv[2][2];
#pragma unroll
        for (int bj = 0; bj < 2; ++bj)
#pragma unroll
            for (int n = 0; n < 2; ++n) bv[bj][n] = *(const f32x4*)(bias + pn * BM + bj * HALF + colw + 4 * n);
        const float sc = pn < 4 ? QSCALE : 1.0f;
#pragma unroll
        for (int ai = 0; ai < 2; ++ai)
#pragma unroll
            for (int m = 0; m < 4; ++m) {
                const int row = row0 + ai * HALF + m * 16, pos = row & 4095;
                f32x4 cs = (f32x4){1.f, 1.f, 1.f, 1.f}, sn = (f32x4){0.f, 0.f, 0.f, 0.f};
                if (pn < 5) { cs = *(const f32x4*)(cosT + pos * 32 + d0); sn = *(const f32x4*)(sinT + pos * 32 + d0); }
                bf16_t* rowp = O + (size_t)row * 1536 + pn * BM + colw;
#pragma unroll
                for (int bj = 0; bj < 2; ++bj) {
                    const f32x4 v0 = acc[ai][bj][m][0] + bv[bj][0], v1 = acc[ai][bj][m][1] + bv[bj][1];
                    const f32x4 o0 = (v0 * cs - v1 * sn) * sc, o1 = (v1 * cs + v0 * sn) * sc;
                    *(u32x4*)(rowp + bj * HALF) = pack8(o0, o1);
                }
            }
    }
};
struct EpiSwiGLU {
    static constexpr bool PERM = true, AFTER_DRAIN = false;
    bf16_t* O;
    __device__ __forceinline__ void operator()(const f32x4 (&acc)[2][2][4][2], const Unit& u, int wr, int wc, int fr, int fq) const {
        const int row0 = u.pm * BM + wr * 64 + fr, col = u.pn * HALF + wc * 32 + 8 * fq;
#pragma unroll
        for (int ai = 0; ai < 2; ++ai)
#pragma unroll
            for (int m = 0; m < 4; ++m) {
                const int row = row0 + ai * HALF + m * 16;
                f32x4 h0, h1;
#pragma unroll
                for (int i = 0; i < 4; ++i) { h0[i] = silu_f(acc[ai][0][m][0][i]) * acc[ai][1][m][0][i]; h1[i] = silu_f(acc[ai][0][m][1][i]) * acc[ai][1][m][1][i]; }
                *(u32x4*)(O + (size_t)row * 2816 + col) = pack8(h0, h1);
            }
    }
};
struct EpiGelu {
    static constexpr bool PERM = true, AFTER_DRAIN = false;
    bf16_t* O; float* stats;
    __device__ __forceinline__ void operator()(const f32x4 (&acc)[2][2][4][2], const Unit& u, int wr, int wc, int fr, int fq) const {
        const int row0 = u.pm * BM + wr * 64 + fr, col = u.pn * BM + wc * 32 + 8 * fq, pn = u.pn;
#pragma unroll
        for (int ai = 0; ai < 2; ++ai)
#pragma unroll
            for (int m = 0; m < 4; ++m) {
                const int row = row0 + ai * HALF + m * 16;
                float s = 0.f, ss = 0.f;
#pragma unroll
                for (int bj = 0; bj < 2; ++bj) {
                    f32x4 z0, z1;
#pragma unroll
                    for (int i = 0; i < 4; ++i) { z0[i] = gelu_f(acc[ai][bj][m][0][i]); z1[i] = gelu_f(acc[ai][bj][m][1][i]); }
                    s += (z0[0] + z0[1]) + (z0[2] + z0[3]) + (z1[0] + z1[1]) + (z1[2] + z1[3]);
                    ss += (z0[0] * z0[0] + z0[1] * z0[1]) + (z0[2] * z0[2] + z0[3] * z0[3]) + (z1[0] * z1[0] + z1[1] * z1[1]) + (z1[2] * z1[2] + z1[3] * z1[3]);
                    *(u32x4*)(O + (size_t)row * 2048 + col + bj * HALF) = pack8(z0, z1);
                }
                if (pn >= 4) {
                    s += __shfl_xor(s, 16); s += __shfl_xor(s, 32); ss += __shfl_xor(ss, 16); ss += __shfl_xor(ss, 32);
                    if (fq == 0) { float* p = stats + ((size_t)row * 16 + (pn - 4) * 4 + wc) * 2; p[0] = s; p[1] = ss; }
                }
            }
    }
};
struct EpiF32 {
    static constexpr bool PERM = false, AFTER_DRAIN = false;
    float* out; int ldc; const float* bias;
    __device__ __forceinline__ void operator()(const f32x4 (&acc)[2][2][4][2], const Unit& u, int wr, int wc, int fr, int fq) const {
        const int row0 = u.pm * BM + wr * 64 + fr, col0 = u.pn * BM + wc * 32 + 4 * fq;
        f32x4 bv[2][2];
#pragma unroll
        for (int bj = 0; bj < 2; ++bj)
#pragma unroll
            for (int n = 0; n < 2; ++n) bv[bj][n] = bias ? *(const f32x4*)(bias + col0 + bj * HALF + n * 16) : (f32x4){0.f, 0.f, 0.f, 0.f};
#pragma unroll
        for (int ai = 0; ai < 2; ++ai)
#pragma unroll
            for (int m = 0; m < 4; ++m) {
                float* rowp = out + (size_t)(row0 + ai * HALF + m * 16) * ldc + col0;
#pragma unroll
                for (int bj = 0; bj < 2; ++bj)
#pragma unroll
                    for (int n = 0; n < 2; ++n) *(f32x4*)(rowp + bj * HALF + n * 16) = acc[ai][bj][m][n] + bv[bj][n];
            }
    }
};

template <class Epi, class Sched, bool ALIGN_EPI = false, bool SP2 = false>
__device__ __forceinline__ void gemm_phase(PG8_LAS unsigned char* lds, const Gemm g, const Sched& S, const Epi& E) {
    const int tid = threadIdx.x, wid = __builtin_amdgcn_readfirstlane(tid >> 6), lane = tid & 63, wr = wid >> 2, wc = wid & 3, fr = lane & 15, fq = lane >> 4;
    const int K = g.K, nt = K / BK;
    unsigned voffA[2], voffB[2];
#pragma unroll
    for (int i = 0; i < 2; ++i) { int R, C; stage_rc(tid * 16 + i * 8192, R, C); const int Rb = Epi::PERM ? ((R & ~31) + perm32(R & 31)) : R;
        voffA[i] = (unsigned)(R * K + C) * 2u; voffB[i] = (unsigned)(Rb * K + C) * 2u; }
    const size_t kstep = (size_t)(BK * 2);
    const size_t hstep = (size_t)HALF * K * 2;
    const size_t tstep = 2 * hstep;
    const unsigned ldsw = (unsigned)wid * 1024u;
    const int aoff = lds_byte(wr * 64 + fr, fq * 8), boff = lds_byte(wc * 32 + fr, fq * 8);
#define PG8_SA(b, h) (((b) * 2 + (h)) * HTB)
#define PG8_SB(b, h) ((4 + (b) * 2 + (h)) * HTB)
#define PG8_STAGE(bufoff, gbase, voff) do { _Pragma("unroll") for (int _i = 0; _i < 2; ++_i) \
        __builtin_amdgcn_global_load_lds((const unsigned*)((const char*)(gbase) + (voff)[_i]), (PG8_LAS unsigned*)(lds + (bufoff) + ldsw + _i * 8192), 16, 0, 0); } while (0)
#define PG8_LDA(dst, b, h) do { _Pragma("unroll") for (int m = 0; m < 4; ++m) _Pragma("unroll") for (int k = 0; k < 2; ++k) dst[m][k] = *(const PG8_LAS bf16x8*)(lds + PG8_SA(b, h) + aoff + m * 2048 + k * 1024); } while (0)
#define PG8_LDB(dst, b, h) do { _Pragma("unroll") for (int n = 0; n < 2; ++n) _Pragma("unroll") for (int k = 0; k < 2; ++k) dst[n][k] = *(const PG8_LAS bf16x8*)(lds + PG8_SB(b, h) + boff + n * 2048 + k * 1024); } while (0)
#define PG8_MMA(ai, bj, At, Bt) do { __builtin_amdgcn_s_setprio(1); _Pragma("unroll") for (int m = 0; m < 4; ++m) _Pragma("unroll") for (int n = 0; n < 2; ++n) _Pragma("unroll") for (int k = 0; k < 2; ++k) \
        acc[ai][bj][m][n] = __builtin_amdgcn_mfma_f32_16x16x32_bf16(Bt[n][k], At[m][k], acc[ai][bj][m][n], 0, 0, 0); __builtin_amdgcn_s_setprio(0); } while (0)
#define PG8_WAIT_V(n) asm volatile("s_waitcnt vmcnt(" #n ")" ::: "memory")
#define PG8_WAIT_L(n) asm volatile("s_waitcnt lgkmcnt(" #n ")" ::: "memory")
#define PG8_BAR __builtin_amdgcn_s_barrier()
#define PG8_SCHED __builtin_amdgcn_sched_barrier(0)
    Unit cur, nxt; int ui = 0;
    if (!S.next(0, cur)) return;
    f32x4 acc[2][2][4][2];
#pragma unroll
    for (int a = 0; a < 2; ++a)
#pragma unroll
        for (int b = 0; b < 2; ++b)
#pragma unroll
            for (int m = 0; m < 4; ++m)
#pragma unroll
                for (int n = 0; n < 2; ++n) acc[a][b][m][n] = (f32x4){0.f, 0.f, 0.f, 0.f};
    bf16x8 At[4][2], B0[2][2], B1[2][2];
    const char* cA = (const char*)g.A + (size_t)cur.pm * tstep; const char* cB = (const char*)g.Bt + (size_t)cur.pn * tstep;
    S.a_ready(cur);
    if constexpr (SP2) {
        PG8_STAGE(PG8_SB(0, 0), cB, voffB); PG8_STAGE(PG8_SB(0, 1), cB + hstep, voffB); PG8_STAGE(PG8_SA(0, 0), cA, voffA); PG8_STAGE(PG8_SA(0, 1), cA + hstep, voffA);
        if (wr == 1) PG8_BAR;
        PG8_WAIT_V(2); PG8_BAR;
        PG8_STAGE(PG8_SB(1, 0), cB + kstep, voffB); PG8_STAGE(PG8_SA(1, 0), cA + kstep, voffA); PG8_STAGE(PG8_SB(1, 1), cB + hstep + kstep, voffB);
        PG8_WAIT_V(6); PG8_BAR;
    } else {
        PG8_STAGE(PG8_SB(0, 0), cB, voffB); PG8_STAGE(PG8_SA(0, 0), cA, voffA); PG8_STAGE(PG8_SB(0, 1), cB + hstep, voffB); PG8_STAGE(PG8_SA(0, 1), cA + hstep, voffA);
        if (wr == 1) PG8_BAR;
        PG8_WAIT_V(4); PG8_BAR;
        PG8_STAGE(PG8_SB(1, 0), cB + kstep, voffB); PG8_STAGE(PG8_SA(1, 0), cA + kstep, voffA); PG8_STAGE(PG8_SB(1, 1), cB + hstep + kstep, voffB);
        PG8_WAIT_V(6); PG8_BAR;
    }
    for (;;) {
        const bool has_next = S.next(ui + 1, nxt);
        const char* nA = has_next ? (const char*)g.A + (size_t)nxt.pm * tstep : cA; const char* nB = has_next ? (const char*)g.Bt + (size_t)nxt.pn * tstep : cB;
        for (int t = 0; t < nt; t += 2) {
            const bool last = (t == nt - 2);
            const char* a1 = cA + (size_t)(t + 1) * kstep;
            const char* a2 = last ? nA : cA + (size_t)(t + 2) * kstep; const char* b2 = last ? nB : cB + (size_t)(t + 2) * kstep;
            const char* a3 = a2 + kstep; const char* b3 = b2 + kstep;
            if (last && has_next) S.a_ready(nxt);
            if constexpr (SP2) {
            PG8_LDB(B0, 0, 0); PG8_LDB(B1, 0, 1); PG8_SCHED; PG8_LDA(At, 0, 0); PG8_STAGE(PG8_SA(1, 1), a1 + hstep, voffA);
            PG8_WAIT_V(8); PG8_WAIT_L(0); PG8_BAR; PG8_MMA(0, 0, At, B0); PG8_MMA(0, 1, At, B1); PG8_BAR; PG8_SCHED;
            PG8_LDA(At, 0, 1); PG8_STAGE(PG8_SB(0, 0), b2, voffB); PG8_STAGE(PG8_SB(0, 1), b2 + hstep, voffB); PG8_STAGE(PG8_SA(0, 0), a2, voffA);
            PG8_WAIT_V(8); PG8_WAIT_L(0); PG8_BAR; PG8_MMA(1, 0, At, B0); PG8_MMA(1, 1, At, B1); PG8_BAR; PG8_SCHED;
            PG8_LDB(B0, 1, 0); PG8_LDB(B1, 1, 1); PG8_SCHED; PG8_LDA(At, 1, 0); PG8_STAGE(PG8_SA(0, 1), a2 + hstep, voffA);
            PG8_WAIT_V(8); PG8_WAIT_L(0); PG8_BAR; PG8_MMA(0, 0, At, B0); PG8_MMA(0, 1, At, B1); PG8_BAR; PG8_SCHED;
            PG8_LDA(At, 1, 1); PG8_STAGE(PG8_SB(1, 0), b3, voffB); PG8_STAGE(PG8_SB(1, 1), b3 + hstep, voffB); PG8_STAGE(PG8_SA(1, 0), a3, voffA);
            PG8_WAIT_V(8); PG8_WAIT_L(0); PG8_BAR; PG8_MMA(1, 0, At, B0); PG8_MMA(1, 1, At, B1); PG8_BAR; PG8_SCHED;
            } else {
            PG8_LDB(B0, 0, 0); PG8_SCHED; PG8_LDA(At, 0, 0); PG8_STAGE(PG8_SA(1, 1), a1 + hstep, voffA);
            PG8_WAIT_L(8); PG8_BAR; PG8_WAIT_L(0); PG8_MMA(0, 0, At, B0); PG8_BAR; PG8_SCHED;
            PG8_LDB(B1, 0, 1); PG8_STAGE(PG8_SB(0, 0), b2, voffB);
            PG8_BAR; PG8_WAIT_L(0); PG8_MMA(0, 1, At, B1); PG8_BAR;
            PG8_LDA(At, 0, 1); PG8_STAGE(PG8_SA(0, 0), a2, voffA);
            PG8_BAR; PG8_WAIT_L(0); PG8_MMA(1, 0, At, B0); PG8_BAR; PG8_SCHED;
            PG8_STAGE(PG8_SB(0, 1), b2 + hstep, voffB);
            PG8_WAIT_V(6); PG8_BAR; PG8_MMA(1, 1, At, B1); PG8_BAR;
            PG8_LDB(B0, 1, 0); PG8_SCHED; PG8_LDA(At, 1, 0); PG8_STAGE(PG8_SA(0, 1), a2 + hstep, voffA);
            PG8_WAIT_L(8); PG8_BAR; PG8_WAIT_L(0); PG8_MMA(0, 0, At, B0); PG8_BAR; PG8_SCHED;
            PG8_LDB(B1, 1, 1); PG8_STAGE(PG8_SB(1, 0), b3, voffB);
            PG8_BAR; PG8_WAIT_L(0); PG8_MMA(0, 1, At, B1); PG8_BAR;
            PG8_LDA(At, 1, 1); PG8_STAGE(PG8_SA(1, 0), a3, voffA);
            PG8_BAR; PG8_WAIT_L(0); PG8_MMA(1, 0, At, B0); PG8_BAR; PG8_SCHED;
            PG8_STAGE(PG8_SB(1, 1), b3 + hstep, voffB);
            PG8_WAIT_V(6); PG8_BAR; PG8_MMA(1, 1, At, B1); PG8_BAR;
            }
        }
        if constexpr (ALIGN_EPI) { if (wr == 0) PG8_BAR; }
        if constexpr (!Epi::AFTER_DRAIN) { E(acc, cur, wr, wc, fr, fq); S.done(cur); }
        if (!has_next) break;
#pragma unroll
        for (int a = 0; a < 2; ++a)
#pragma unroll
            for (int b = 0; b < 2; ++b)
#pragma unroll
                for (int m = 0; m < 4; ++m)
#pragma unroll
                    for (int n = 0; n < 2; ++n) acc[a][b][m][n] = (f32x4){0.f, 0.f, 0.f, 0.f};
        cur = nxt; cA = nA; cB = nB; ++ui;
        if constexpr (ALIGN_EPI) { if (wr == 1) PG8_BAR; }
    }
    PG8_WAIT_V(0);
    if constexpr (!ALIGN_EPI) { if (wr == 0) PG8_BAR; }
    PG8_BAR;
    if constexpr (Epi::AFTER_DRAIN) { E.fused(acc, cur, wr, wc, fr, fq, lds, wid, lane); S.done(cur); }
#undef PG8_SA
#undef PG8_SB
#undef PG8_STAGE
#undef PG8_LDA
#undef PG8_LDB
#undef PG8_MMA
#undef PG8_WAIT_V
#undef PG8_WAIT_L
#undef PG8_BAR
#undef PG8_SCHED
}
}

#ifndef PG8_SP2
#define PG8_SP2 true
#endif
#ifndef PG8_ALIGN
#define PG8_ALIGN true
#endif
#ifndef MK_SPLIT
#define MK_SPLIT 0
#endif

constexpr int NWAVES = 8;
constexpr int BATCH = 8, SEQ = 4096, D = 1024, M = BATCH * SEQ;
constexpr int NQKV = 1536, DFF = 2816, NGU = 2 * DFF, NZ = 2048;
constexpr float EPS = 1e-6f;
constexpr float LOG2E = 1.4426950408889634f;

constexpr size_t MiB = 1u << 20;
constexpr size_t WS_WQKV = 2 * MiB;
constexpr size_t WS_WO = 5 * MiB;
constexpr size_t WS_WIN = 7 * MiB;
constexpr size_t WS_WOUT = 11 * MiB;
constexpr size_t WS_WGU0 = 13 * MiB;
constexpr size_t WS_WGU1 = 24 * MiB;
constexpr size_t WS_WDN0 = 35 * MiB;
constexpr size_t WS_WDN1 = 41 * MiB;
constexpr size_t WS_WSB = 47 * MiB;
constexpr size_t WS_COS = 48 * MiB;
constexpr size_t WS_SIN = 49 * MiB;
constexpr size_t WS_BQKV = 50 * MiB;
constexpr size_t WS_STATS = 52 * MiB;
constexpr size_t WS_XN = 64 * MiB;
constexpr size_t WS_R1 = 128 * MiB;
constexpr size_t WS_QKV = WS_R1, WS_O = WS_R1 + 96 * MiB, WS_Z = WS_R1, WS_Y = WS_R1 + 128 * MiB, WS_H = WS_R1;
constexpr size_t WS_MO = 320 * MiB;
constexpr size_t WS_END = 448 * MiB;

constexpr int RING_BYTES = 131072;
constexpr int LDS_BYTES = 147456;

#define LAS __attribute__((address_space(3)))
typedef unsigned short bf16;
typedef unsigned v4u __attribute__((ext_vector_type(4)));
typedef unsigned v2u __attribute__((ext_vector_type(2)));
typedef float f32x4 __attribute__((ext_vector_type(4)));
typedef float f32x16 __attribute__((ext_vector_type(16)));
typedef short bf16x8 __attribute__((ext_vector_type(8)));
typedef short v4i16_t __attribute__((ext_vector_type(4)));
#define LDS_WAIT() asm volatile("s_waitcnt lgkmcnt(0)" ::: "memory")
__device__ __forceinline__ unsigned f2bf(float f) { unsigned u = __builtin_bit_cast(unsigned, f); return (u + 0x7fffu + ((u >> 16) & 1u)) >> 16; }
__device__ __forceinline__ unsigned pk2(float lo, float hi) { return f2bf(lo) | (f2bf(hi) << 16); }
__device__ __forceinline__ float bf_lo(unsigned w) { return __builtin_bit_cast(float, w << 16); }
__device__ __forceinline__ float bf_hi(unsigned w) { return __builtin_bit_cast(float, w & 0xffff0000u); }
__device__ __forceinline__ float wave_sum(float v) {
#pragma unroll
    for (int o = 1; o < 64; o <<= 1) v += __shfl_xor(v, o);
    return v;
}
__device__ __forceinline__ bf16x8 tr_pair(const LAS unsigned char* p0, const LAS unsigned char* p1) {
    const v4i16_t a = __builtin_amdgcn_ds_read_tr16_b64_v4i16((LAS v4i16_t*)p0), b = __builtin_amdgcn_ds_read_tr16_b64_v4i16((LAS v4i16_t*)p1);
    return (bf16x8){a[0], a[1], a[2], a[3], b[0], b[1], b[2], b[3]};
}


typedef __attribute__((address_space(1))) unsigned gu32;
constexpr size_t WS_CTL = 0, CTL_ZERO_BYTES = 1u << 20;
constexpr int CW_BAR = 4096;
#define XB_TMO      128
#define XB_XCNT(j)  (256  + 64 * (j))
#define XB_XSUB(j)  (1280 + 64 * (j))
#define XB_XGEN(j)  (2304 + 64 * (j))
#define XB_TOP      3328
#define XB_TOPGEN   3392
#define XCD_BAR_WORDS 3456
#define XB_SPIN_CAP (1u << 18)

__device__ __forceinline__ unsigned xb_ld(unsigned* p)              { return __hip_atomic_load(p, __ATOMIC_RELAXED, __HIP_MEMORY_SCOPE_AGENT); }
__device__ __forceinline__ unsigned xb_add(unsigned* p, unsigned v) { return __hip_atomic_fetch_add(p, v, __ATOMIC_RELAXED, __HIP_MEMORY_SCOPE_AGENT); }
__device__ __forceinline__ unsigned xb_xcc_id() { return (unsigned)__builtin_amdgcn_s_getreg((3 << 11) | 20) & 0xFu; }
#define XB_SPIN(cond, bar) do { unsigned _sp = 0; while (cond) { __builtin_amdgcn_s_sleep(1); \
    if ((++_sp & 255u) == 0u) { if (xb_ld(&(bar)[XB_TMO])) break; if (_sp > XB_SPIN_CAP) { atomicAdd(&(bar)[XB_TMO], 1u); break; } } } } while (0)

struct XcdBarrier {
    unsigned* bar; unsigned x;
    volatile LAS unsigned* st;
};

__device__ __forceinline__ XcdBarrier xcd_barrier_post(unsigned* bar, volatile LAS unsigned* st) {
    XcdBarrier b; b.bar = bar; b.x = xb_xcc_id(); b.st = st;
    if (threadIdx.x == 0) (void)xb_add(&bar[XB_XCNT(b.x)], 1u);
    return b;
}
__device__ __forceinline__ void xcd_barrier_complete(unsigned* bar, unsigned x, unsigned& nloc, unsigned& nx) {
    const unsigned G = gridDim.x * gridDim.y * gridDim.z;
    unsigned sum, cnt, mine, sp = 0u;
    for (;;) {
        sum = 0u; cnt = 0u; mine = 0u;
#pragma unroll
        for (unsigned j = 0; j < 16; ++j) { const unsigned c = xb_ld(&bar[XB_XCNT(j)]); sum += c; cnt += (c > 0u) ? 1u : 0u; mine = (j == x) ? c : mine; }
        if (sum == G) break;
        __builtin_amdgcn_s_sleep(1);
        if ((++sp & 255u) == 0u) { if (xb_ld(&bar[XB_TMO])) break; if (sp > XB_SPIN_CAP) { atomicAdd(&bar[XB_TMO], 1u); break; } }
    }
    nloc = mine > 0u ? mine : 1u; nx = cnt > 0u ? cnt : 1u;
}

__device__ __forceinline__ void xcd_barrier(const XcdBarrier& b) {
    asm volatile("s_waitcnt vmcnt(0)" ::: "memory");
    __syncthreads();
    if (threadIdx.x == 0) {
        unsigned* bar = b.bar;
        __builtin_amdgcn_s_waitcnt(0);
        unsigned nloc = b.st[0], nx = b.st[1];
        if (nloc == 0u) { xcd_barrier_complete(bar, b.x, nloc, nx); b.st[0] = nloc; b.st[1] = nx; }
        const unsigned old = xb_add(&bar[XB_XSUB(b.x)], 1u);
        const unsigned gen = old / nloc;
        if (old + 1u == (gen + 1u) * nloc) {
            __builtin_amdgcn_fence(__ATOMIC_RELEASE, "agent");
            asm volatile("s_waitcnt vmcnt(0)" ::: "memory");
            const unsigned og = xb_add(&bar[XB_TOP], 1u);
            const unsigned tg = og / nx;
            if (og + 1u == (tg + 1u) * nx) xb_add(&bar[XB_TOPGEN], 1u);
            else XB_SPIN(xb_ld(&bar[XB_TOPGEN]) == tg, bar);
            __builtin_amdgcn_fence(__ATOMIC_ACQUIRE, "agent");
            xb_add(&bar[XB_XGEN(b.x)], 1u);
            asm volatile("s_waitcnt vmcnt(0)" ::: "memory");
        } else {
            XB_SPIN(xb_ld(&bar[XB_XGEN(b.x)]) == gen, bar);
            __builtin_amdgcn_fence(__ATOMIC_ACQUIRE, "agent");
            asm volatile("s_waitcnt vmcnt(0)" ::: "memory");
        }
    }
    __syncthreads();
}

__device__ __forceinline__ int dst_row(int mode, int n) {
    if (mode == 1) { if (n >= 1280) return n; const int h = n >> 6, d = n & 63, J = (d & 31) >> 2, e = (d & 3) + ((d >> 5) << 2); return h * 64 + 8 * J + e; }
    if (mode == 2) { const int up = n >= DFF ? 1 : 0, c = n - up * DFF; return (c >> 7) * 256 + up * 128 + (c & 127); }
    return n;
}
__device__ __forceinline__ void p0_transpose_item(const float* W, int K, int N, bf16* WT, int mode, LAS float* scr, int item, int lane) {
    const int nblk = N / 32, kb = item / nblk, nb = item % nblk, k0 = 64 * kb, n0 = 32 * nb;
#pragma unroll 8
    for (int i = 0; i < 32; ++i) { const int kk = 2 * i + (lane >> 5); scr[kk * 33 + (lane & 31)] = W[(size_t)(k0 + kk) * N + n0 + (lane & 31)]; }
    LDS_WAIT(); asm volatile("" ::: "memory");
    const int c = lane & 7;
#pragma unroll
    for (int j = 0; j < 4; ++j) { const int n = (lane >> 3) + 8 * j; const LAS float* s = scr + (8 * c) * 33 + n;
        v4u o; o.x = pk2(s[0 * 33], s[1 * 33]); o.y = pk2(s[2 * 33], s[3 * 33]); o.z = pk2(s[4 * 33], s[5 * 33]); o.w = pk2(s[6 * 33], s[7 * 33]);
        *(v4u*)(WT + (size_t)dst_row(mode, n0 + n) * K + k0 + 8 * c) = o; }
    LDS_WAIT(); asm volatile("" ::: "memory");
}
__device__ __forceinline__ void rms_row_to_bf16(const float* xrow, const float* g, bf16* orow, int lane) {
    const f32x4* xr = (const f32x4*)xrow + lane; const f32x4* gr = (const f32x4*)g + lane;
    f32x4 v[4]; float s = 0.f;
#pragma unroll
    for (int j = 0; j < 4; ++j) { v[j] = xr[64 * j]; s += (v[j].x * v[j].x + v[j].y * v[j].y) + (v[j].z * v[j].z + v[j].w * v[j].w); }
    const float rs = 1.0f / sqrtf(wave_sum(s) * (1.f / D) + EPS);
    unsigned long long* o8 = (unsigned long long*)orow + lane;
#pragma unroll
    for (int j = 0; j < 4; ++j) { const f32x4 gg = gr[64 * j]; const f32x4 y = v[j] * rs * gg; o8[64 * j] = (unsigned long long)pk2(y.x, y.y) | ((unsigned long long)pk2(y.z, y.w) << 32); }
}
__device__ __forceinline__ void norm_res_norm_rows(const float* x_in, const float* mo, const float* g_post, float* x_out, const float* g_pre, bf16* xn, int gw, int NGW, int lane) {
    for (int m = gw; m < M; m += NGW) {
        const f32x4* mr = (const f32x4*)(mo + (size_t)m * D) + lane; const f32x4* xr = (const f32x4*)(x_in + (size_t)m * D) + lane;
        f32x4 v[4], xv[4]; float s = 0.f;
#pragma unroll
        for (int j = 0; j < 4; ++j) { v[j] = mr[64 * j]; xv[j] = xr[64 * j]; s += (v[j].x * v[j].x + v[j].y * v[j].y) + (v[j].z * v[j].z + v[j].w * v[j].w); }
        const float rs = 1.0f / sqrtf(wave_sum(s) * (1.f / D) + EPS);
        float s2 = 0.f; f32x4* xo = (f32x4*)(x_out + (size_t)m * D) + lane;
#pragma unroll
        for (int j = 0; j < 4; ++j) { const f32x4 gg = ((const f32x4*)g_post + lane)[64 * j]; xv[j] = xv[j] + v[j] * rs * gg; xo[64 * j] = xv[j];
            s2 += (xv[j].x * xv[j].x + xv[j].y * xv[j].y) + (xv[j].z * xv[j].z + xv[j].w * xv[j].w); }
        if (xn) {
            const float rs2 = 1.0f / sqrtf(wave_sum(s2) * (1.f / D) + EPS);
            unsigned long long* o8 = (unsigned long long*)(xn + (size_t)m * D) + lane;
#pragma unroll
            for (int j = 0; j < 4; ++j) { const f32x4 gg = ((const f32x4*)g_pre + lane)[64 * j]; const f32x4 y = xv[j] * rs2 * gg; o8[64 * j] = (unsigned long long)pk2(y.x, y.y) | ((unsigned long long)pk2(y.z, y.w) << 32); }
        }
    }
}

constexpr int ATT_RS = 144, ATT_K = 0, ATT_V = 256 * ATT_RS;
__device__ __forceinline__ void attn_phase(LAS unsigned char* lds, const bf16* QKV, bf16* O, const float* sinks, int vcu, int G) {
    const int tid = threadIdx.x, lane = tid & 63, r32 = lane & 31, hi = lane >> 5; const int wid = __builtin_amdgcn_readfirstlane(tid >> 6);
    const int sig = (r32 & ~12) | ((r32 & 4) << 1) | ((r32 & 8) >> 1);
    for (int unit = vcu; unit < BATCH * 32 * 4; unit += G) {
        const int kvh = unit & 3, nb = (unit >> 2) & 31, b = unit >> 7;
        __syncthreads();
        const long tok0 = (long)b * SEQ + (nb - 1) * 128;
#pragma unroll
        for (int i = 0; i < 4; ++i) {
            const int c = tid + 512 * i, row = c >> 3, ch = c & 7;
            v4u kq = (v4u){0u, 0u, 0u, 0u}, vq = (v4u){0u, 0u, 0u, 0u};
            if (nb > 0 || row >= 128) { const bf16* src = QKV + (tok0 + row) * NQKV + 1024 + kvh * 64 + ch * 8; kq = *(const v4u*)src; vq = *(const v4u*)(src + 256); }
            *(LAS v4u*)(lds + ATT_K + row * ATT_RS + ch * 16) = kq; *(LAS v4u*)(lds + ATT_V + row * ATT_RS + ch * 16) = vq;
        }
        __syncthreads();
        const int head = kvh * 4 + (wid >> 1);
        const float sink2 = sinks[head] * LOG2E;
        for (int sb = 0; sb < 2; ++sb) {
            const int s = 2 * (wid & 1) + sb;
            const long qtok = (long)b * SEQ + nb * 128 + 32 * s + r32;
            bf16x8 qf[4];
#pragma unroll
            for (int ds = 0; ds < 4; ++ds) qf[ds] = *(const bf16x8*)(QKV + qtok * NQKV + head * 64 + 16 * ds + 8 * hi);
            f32x16 S[5];
#pragma unroll
            for (int jt = 0; jt < 5; ++jt) {
                f32x16 a = {};
                const LAS unsigned char* kp = lds + ATT_K + (32 * (s + jt) + sig) * ATT_RS + 16 * hi;
#pragma unroll
                for (int ds = 0; ds < 4; ++ds) { const bf16x8 kf = *(const LAS bf16x8*)(kp + 32 * ds); a = __builtin_amdgcn_mfma_f32_32x32x16_bf16(kf, qf[ds], a, 0, 0, 0); }
                S[jt] = a;
            }
            const float NEG = -INFINITY;
#pragma unroll
            for (int r = 0; r < 16; ++r) { const int kt = 16 * (r >> 3) + 8 * hi + (r & 7); if (kt <= r32) S[0][r] = NEG; if (kt > r32) S[4][r] = NEG; }
            if (nb == 0) {
#pragma unroll
                for (int jt = 0; jt < 4; ++jt) if (jt < 4 - s) {
#pragma unroll
                    for (int r = 0; r < 16; ++r) S[jt][r] = NEG; }
            }
            float mx = sink2;
#pragma unroll
            for (int jt = 0; jt < 5; ++jt)
#pragma unroll
                for (int r = 0; r < 16; ++r) mx = fmaxf(mx, S[jt][r]);
            mx = fmaxf(mx, __shfl_xor(mx, 32));
            float sum = 0.f;
#pragma unroll
            for (int jt = 0; jt < 5; ++jt)
#pragma unroll
                for (int r = 0; r < 16; ++r) { const float p = __builtin_amdgcn_exp2f(S[jt][r] - mx); S[jt][r] = p; sum += p; }
            sum += __shfl_xor(sum, 32); sum += __builtin_amdgcn_exp2f(sink2 - mx);
            f32x16 o0 = {}, o1 = {};
            const int blk = (lane >> 4) & 1, qq = (lane & 15) >> 2, p4 = lane & 3;
            const LAS unsigned char* vp = lds + ATT_V + (32 * s + 8 * hi + qq) * ATT_RS + 32 * blk + 8 * p4;
#pragma unroll
            for (int ks = 0; ks < 10; ++ks) {
                const int jt = ks >> 1, h8 = (ks & 1) * 8;
                v4u pw; pw.x = pg8::cvt_pk_bf16(S[jt][h8 + 0], S[jt][h8 + 1]); pw.y = pg8::cvt_pk_bf16(S[jt][h8 + 2], S[jt][h8 + 3]); pw.z = pg8::cvt_pk_bf16(S[jt][h8 + 4], S[jt][h8 + 5]); pw.w = pg8::cvt_pk_bf16(S[jt][h8 + 6], S[jt][h8 + 7]);
                const bf16x8 pf = __builtin_bit_cast(bf16x8, pw);
                const LAS unsigned char* vk = vp + 16 * ks * ATT_RS;
                const bf16x8 va0 = tr_pair(vk, vk + 4 * ATT_RS), va1 = tr_pair(vk + 64, vk + 64 + 4 * ATT_RS);
                o0 = __builtin_amdgcn_mfma_f32_32x32x16_bf16(va0, pf, o0, 0, 0, 0);
                o1 = __builtin_amdgcn_mfma_f32_32x32x16_bf16(va1, pf, o1, 0, 0, 0);
            }
            const float inv = 1.0f / sum;
            bf16* op = O + qtok * D + head * 64 + 4 * hi;
#pragma unroll
            for (int rg = 0; rg < 4; ++rg) {
                v2u w0, w1;
                w0.x = pg8::cvt_pk_bf16(o0[4 * rg] * inv, o0[4 * rg + 1] * inv); w0.y = pg8::cvt_pk_bf16(o0[4 * rg + 2] * inv, o0[4 * rg + 3] * inv);
                w1.x = pg8::cvt_pk_bf16(o1[4 * rg] * inv, o1[4 * rg + 1] * inv); w1.y = pg8::cvt_pk_bf16(o1[4 * rg + 2] * inv, o1[4 * rg + 3] * inv);
                *(v2u*)(op + 8 * rg) = w0; *(v2u*)(op + 32 + 8 * rg) = w1;
            }
        }
    }
    __syncthreads();
}

constexpr int SG_RS = 272, SG_TV = 0, SG_TS = 128 * SG_RS, SG_ST = 2 * 128 * SG_RS;
__device__ __forceinline__ void sgu_phase(LAS unsigned char* lds, const bf16* Z, bf16* Y, const float* stats, const float* lng, const float* lnb, const bf16* wsb, const float* bsp, int vcu, int G) {
    const int tid = threadIdx.x, lane = tid & 63, r32 = lane & 31, hi = lane >> 5; const int wid = __builtin_amdgcn_readfirstlane(tid >> 6);
    LAS float* st = (LAS float*)(lds + SG_ST);
    for (int unit = vcu; unit < 256 * 8; unit += G) {
        const int g = unit & 7, c = unit >> 3; const long tok0 = (long)c * 128;
        __syncthreads();
        if (tid < 128) {
            const f32x4* sp = (const f32x4*)(stats + (tok0 + tid) * 32); float s = 0.f, ss = 0.f;
#pragma unroll
            for (int k = 0; k < 8; ++k) { const f32x4 q = sp[k]; s += q.x + q.z; ss += q.y + q.w; }
            const float mu = s * (1.f / 1024.f), var = ss * (1.f / 1024.f) - mu * mu;
            st[2 * tid] = mu; st[2 * tid + 1] = 1.0f / sqrtf(fmaxf(var, 0.f) + EPS);
        }
        __syncthreads();
#pragma unroll
        for (int i = 0; i < 4; ++i) {
            const int idx = tid + 512 * i, row = idx >> 4, ch = idx & 15;
            const v4u q = *(const v4u*)(Z + (tok0 + row) * NZ + 1024 + g * 128 + ch * 8);
            const float mu = st[2 * row], rs = st[2 * row + 1];
            const f32x4 g0 = *(const f32x4*)(lng + g * 128 + ch * 8), g1 = *(const f32x4*)(lng + g * 128 + ch * 8 + 4), b0 = *(const f32x4*)(lnb + g * 128 + ch * 8), b1 = *(const f32x4*)(lnb + g * 128 + ch * 8 + 4);
            v4u o;
            o.x = pk2((bf_lo(q.x) - mu) * rs * g0.x + b0.x, (bf_hi(q.x) - mu) * rs * g0.y + b0.y); o.y = pk2((bf_lo(q.y) - mu) * rs * g0.z + b0.z, (bf_hi(q.y) - mu) * rs * g0.w + b0.w);
            o.z = pk2((bf_lo(q.z) - mu) * rs * g1.x + b1.x, (bf_hi(q.z) - mu) * rs * g1.y + b1.y); o.w = pk2((bf_lo(q.w) - mu) * rs * g1.z + b1.z, (bf_hi(q.w) - mu) * rs * g1.w + b1.w);
            *(LAS v4u*)(lds + SG_TV + row * SG_RS + ch * 16) = o;
        }
        __syncthreads();
        {
            const int db = wid >> 1;
            const int blk = (lane >> 4) & 1, qq = (lane & 15) >> 2, p4 = lane & 3;
            const LAS unsigned char* vp = lds + SG_TV + (8 * hi + qq) * SG_RS + 64 * db + 32 * blk + 8 * p4;
#pragma unroll
            for (int ti = 0; ti < 2; ++ti) {
                const int tb = (wid & 1) ? (1 + ti) : (3 * ti);
                f32x16 a = {};
                const bf16* wrow = wsb + ((size_t)g * 128 + tb * 32 + r32) * 128 + 8 * hi;
                for (int ks = 0; ks < 2 * (tb + 1); ++ks) {
                    const bf16x8 wf = *(const bf16x8*)(wrow + 16 * ks);
                    const LAS unsigned char* vk = vp + 16 * ks * SG_RS;
                    const bf16x8 va = tr_pair(vk, vk + 4 * SG_RS);
                    a = __builtin_amdgcn_mfma_f32_32x32x16_bf16(va, wf, a, 0, 0, 0);
                }
                const float bs = bsp[g * 128 + tb * 32 + r32];
                LAS unsigned char* tp = lds + SG_TS + (tb * 32 + r32) * SG_RS + (db * 32 + 4 * hi) * 2;
#pragma unroll
                for (int rg = 0; rg < 4; ++rg) { v2u w; w.x = pg8::cvt_pk_bf16(a[4 * rg] + bs, a[4 * rg + 1] + bs); w.y = pg8::cvt_pk_bf16(a[4 * rg + 2] + bs, a[4 * rg + 3] + bs); *(LAS v2u*)(tp + 16 * rg) = w; }
            }
        }
        __syncthreads();
#pragma unroll
        for (int i = 0; i < 4; ++i) {
            const int idx = tid + 512 * i, row = idx >> 4, ch = idx & 15;
            const v4u mq = *(const LAS v4u*)(lds + SG_TS + row * SG_RS + ch * 16);
            const v4u uq = *(const v4u*)(Z + (tok0 + row) * NZ + g * 128 + ch * 8);
            v4u o;
            o.x = pk2(bf_lo(mq.x) * bf_lo(uq.x), bf_hi(mq.x) * bf_hi(uq.x)); o.y = pk2(bf_lo(mq.y) * bf_lo(uq.y), bf_hi(mq.y) * bf_hi(uq.y));
            o.z = pk2(bf_lo(mq.z) * bf_lo(uq.z), bf_hi(mq.z) * bf_hi(uq.z)); o.w = pk2(bf_lo(mq.w) * bf_lo(uq.w), bf_hi(mq.w) * bf_hi(uq.w));
            *(v4u*)(Y + (tok0 + row) * D + g * 128 + ch * 8) = o;
        }
    }
    __syncthreads();
}

struct Args { const float* in[18]; float* out; unsigned char* ws; int ph_lo, ph_hi; };
constexpr int N_PHASES = 15;

__global__ void __launch_bounds__(NWAVES * 64, 2) mega_fwd(Args args) {
    extern __shared__ __attribute__((aligned(16))) unsigned char lds_raw[];
    LAS unsigned char* lds = (LAS unsigned char*)lds_raw;
    cg::grid_group grid = cg::this_grid();
    const int tid = threadIdx.x, lane = tid & 63, wave = __builtin_amdgcn_readfirstlane(tid >> 6);
    const int G = gridDim.x, bx = blockIdx.x;
    const int vcu = (G % 8 == 0) ? (bx % 8) * (G / 8) + bx / 8 : bx;
    const int gw = vcu * NWAVES + wave, NGW = G * NWAVES;
    unsigned char* ws = args.ws;
    const float* x = args.in[0];
    const float *g_mix_pre = args.in[1], *g_mix_post = args.in[2], *g_ffn_pre = args.in[3], *g_ffn_post = args.in[4];
    const float *w_qkv = args.in[5], *b_qkv = args.in[6], *sinks = args.in[7], *w_o = args.in[8], *b_o = args.in[9];
    const float *w_in = args.in[10], *ln_g = args.in[11], *ln_b = args.in[12], *w_sp = args.in[13], *b_sp = args.in[14], *w_out = args.in[15];
    const float *w_gu = args.in[16], *w_dn = args.in[17];
    float* out = args.out;
    bf16 *Wqkv_t = (bf16*)(ws + WS_WQKV), *Wo_t = (bf16*)(ws + WS_WO), *Win_t = (bf16*)(ws + WS_WIN), *Wout_t = (bf16*)(ws + WS_WOUT);
    bf16 *Wgu0 = (bf16*)(ws + WS_WGU0), *Wgu1 = (bf16*)(ws + WS_WGU1), *Wdn0 = (bf16*)(ws + WS_WDN0), *Wdn1 = (bf16*)(ws + WS_WDN1), *wsb = (bf16*)(ws + WS_WSB);
    float *cosT = (float*)(ws + WS_COS), *sinT = (float*)(ws + WS_SIN), *bqkvP = (float*)(ws + WS_BQKV), *stats = (float*)(ws + WS_STATS), *MO = (float*)(ws + WS_MO);
    bf16 *XN = (bf16*)(ws + WS_XN), *QKV = (bf16*)(ws + WS_QKV), *OB = (bf16*)(ws + WS_O), *ZB = (bf16*)(ws + WS_Z), *YB = (bf16*)(ws + WS_Y), *HB = (bf16*)(ws + WS_H);

    const int lo = args.ph_lo, hi = args.ph_hi;
    volatile LAS unsigned* MISC = (volatile LAS unsigned*)(lds + RING_BYTES);
    if (tid < 16) MISC[tid] = 0u;
    __syncthreads();
    XcdBarrier bar; bar.bar = (unsigned*)(ws + WS_CTL) + CW_BAR; bar.x = 0; bar.st = nullptr;
    if (hi - lo > 1) bar = xcd_barrier_post((unsigned*)(ws + WS_CTL) + CW_BAR, MISC + 8);
#define IN(k) (lo <= (k) && (k) < hi)
#define SEAM(k) do { if (IN(k) && IN((k) + 1)) { if ((k) == 0) grid.sync(); else xcd_barrier(bar); } } while (0)

    if (IN(0)) {
        LAS float* scr = (LAS float*)(lds + wave * 16384);
        constexpr int I_QKV = 16 * 48, I_O = 16 * 32, I_IN = 16 * 64, I_OUT = 16 * 32, I_GU = 16 * 176, I_DN = 44 * 32;
        constexpr int NITEMS = I_QKV + I_O + I_IN + I_OUT + 2 * I_GU + 2 * I_DN;
        for (int it = gw; it < NITEMS; it += NGW) {
            int r = it;
            if (r < I_QKV) { p0_transpose_item(w_qkv, D, NQKV, Wqkv_t, 1, scr, r, lane); continue; } r -= I_QKV;
            if (r < I_O) { p0_transpose_item(w_o, D, D, Wo_t, 0, scr, r, lane); continue; } r -= I_O;
            if (r < I_IN) { p0_transpose_item(w_in, D, NZ, Win_t, 0, scr, r, lane); continue; } r -= I_IN;
            if (r < I_OUT) { p0_transpose_item(w_out, D, D, Wout_t, 0, scr, r, lane); continue; } r -= I_OUT;
            if (r < I_GU) { p0_transpose_item(w_gu, D, NGU, Wgu0, 2, scr, r, lane); continue; } r -= I_GU;
            if (r < I_GU) { p0_transpose_item(w_gu + (size_t)D * NGU, D, NGU, Wgu1, 2, scr, r, lane); continue; } r -= I_GU;
            if (r < I_DN) { p0_transpose_item(w_dn, DFF, D, Wdn0, 0, scr, r, lane); continue; } r -= I_DN;
            p0_transpose_item(w_dn + (size_t)DFF * D, DFF, D, Wdn1, 0, scr, r, lane);
        }
        const int gt = vcu * (NWAVES * 64) + tid, NGT = G * NWAVES * 64;
        for (int i = gt; i < 8 * 128 * 128; i += NGT) { const int s = i & 127, t = (i >> 7) & 127; wsb[i] = (bf16)f2bf(s <= t ? w_sp[i] : 0.f); }
        for (int i = gt; i < SEQ * 32; i += NGT) {
            const int pos = i >> 5, j = i & 31;
            const float inv_freq = exp2f(-(float)(2 * j) * (1.0f / 64.0f) * 13.287712379549449f);
            const float ang = (float)pos * inv_freq;
            const double a = (double)ang, k = rint(a * 0.15915494309189535), rr = a - k * 6.283185307179586;
            cosT[i] = cosf((float)rr); sinT[i] = sinf((float)rr);
        }
        for (int i = gt; i < NQKV; i += NGT) {
            int src = i;
            if (i < 1280) { const int h = i >> 6, p = i & 63, J = p >> 3, e = p & 7; src = h * 64 + (e < 4 ? 4 * J + e : 32 + 4 * J + (e - 4)); }
            bqkvP[i] = b_qkv[src];
        }
        for (int m = gw; m < M; m += NGW) rms_row_to_bf16(x + (size_t)m * D, g_mix_pre, XN + (size_t)m * D, lane);
    }
    SEAM(0);
    if (IN(1)) { pg8::Gemm g{XN, Wqkv_t, M, NQKV, D}; pg8::StaticOrder S; S.init(M, NQKV, G, bx); pg8::EpiQKV E{QKV, bqkvP, cosT, sinT};
        pg8::gemm_phase<pg8::EpiQKV, pg8::StaticOrder, PG8_ALIGN, PG8_SP2>(lds, g, S, E); }
    SEAM(1);
    if (IN(2)) attn_phase(lds, QKV, OB, sinks, vcu, G);
    SEAM(2);
    if (IN(3)) { pg8::Gemm g{OB, Wo_t, M, D, D}; pg8::StaticOrder S; S.init(M, D, G, bx); pg8::EpiF32 E{MO, D, b_o};
        pg8::gemm_phase<pg8::EpiF32, pg8::StaticOrder, PG8_ALIGN, PG8_SP2>(lds, g, S, E); }
    SEAM(3);
    if (IN(4)) norm_res_norm_rows(x, MO, g_mix_post, out, g_ffn_pre, XN, gw, NGW, lane);
    SEAM(4);
    if (IN(5)) { pg8::Gemm g{XN, Wgu0, M, NGU, D}; pg8::StaticOrder S; S.init(M, NGU, G, bx); pg8::EpiSwiGLU E{HB};
        pg8::gemm_phase<pg8::EpiSwiGLU, pg8::StaticOrder, PG8_ALIGN, PG8_SP2>(lds, g, S, E); }
    SEAM(5);
    if (IN(6)) { pg8::Gemm g{HB, Wdn0, M, D, DFF}; pg8::StaticOrder S; S.init(M, D, G, bx); pg8::EpiF32 E{MO, D, nullptr};
        pg8::gemm_phase<pg8::EpiF32, pg8::StaticOrder, PG8_ALIGN, PG8_SP2>(lds, g, S, E); }
    SEAM(6);
    if (IN(7)) norm_res_norm_rows(out, MO, g_ffn_post, out, g_mix_pre + D, XN, gw, NGW, lane);
    SEAM(7);
    if (IN(8)) { pg8::Gemm g{XN, Win_t, M, NZ, D}; pg8::StaticOrder S; S.init(M, NZ, G, bx); pg8::EpiGelu E{ZB, stats};
        pg8::gemm_phase<pg8::EpiGelu, pg8::StaticOrder, PG8_ALIGN, PG8_SP2>(lds, g, S, E); }
    SEAM(8);
    if (IN(9)) sgu_phase(lds, ZB, YB, stats, ln_g, ln_b, wsb, b_sp, vcu, G);
    SEAM(9);
    if (IN(10)) { pg8::Gemm g{YB, Wout_t, M, D, D}; pg8::StaticOrder S; S.init(M, D, G, bx); pg8::EpiF32 E{MO, D, nullptr};
        pg8::gemm_phase<pg8::EpiF32, pg8::StaticOrder, PG8_ALIGN, PG8_SP2>(lds, g, S, E); }
    SEAM(10);
    if (IN(11)) norm_res_norm_rows(out, MO, g_mix_post + D, out, g_ffn_pre + D, XN, gw, NGW, lane);
    SEAM(11);
    if (IN(12)) { pg8::Gemm g{XN, Wgu1, M, NGU, D}; pg8::StaticOrder S; S.init(M, NGU, G, bx); pg8::EpiSwiGLU E{HB};
        pg8::gemm_phase<pg8::EpiSwiGLU, pg8::StaticOrder, PG8_ALIGN, PG8_SP2>(lds, g, S, E); }
    SEAM(12);
    if (IN(13)) { pg8::Gemm g{HB, Wdn1, M, D, DFF}; pg8::StaticOrder S; S.init(M, D, G, bx); pg8::EpiF32 E{MO, D, nullptr};
        pg8::gemm_phase<pg8::EpiF32, pg8::StaticOrder, PG8_ALIGN, PG8_SP2>(lds, g, S, E); }
    SEAM(13);
    if (IN(14)) norm_res_norm_rows(out, MO, g_ffn_post + D, out, nullptr, nullptr, gw, NGW, lane);
#undef IN
#undef SEAM
}

extern "C" void kernel_launch(void* const* d_in, const int* in_sizes, int n_in, void* d_out, int out_size, void* d_ws, size_t ws_size, hipStream_t stream) {
    static int grid = 0;
    if (grid == 0) {
        if (n_in != 18 || in_sizes[0] != M * D || out_size != M * D || ws_size < WS_END) { fprintf(stderr, "kernel_launch: unexpected shapes (n_in %d, in0 %d, out %d, ws %zu); nothing launched\n", n_in, n_in > 0 ? in_sizes[0] : -1, out_size, ws_size); grid = -1; return; }
        int dev = 0, cus = 0, per_cu = 0;
        if (hipGetDevice(&dev) != hipSuccess || hipDeviceGetAttribute(&cus, hipDeviceAttributeMultiprocessorCount, dev) != hipSuccess) { grid = -1; return; }
        if (hipFuncSetAttribute((const void*)mega_fwd, hipFuncAttributeMaxDynamicSharedMemorySize, LDS_BYTES) != hipSuccess) { fprintf(stderr, "kernel_launch: hipFuncSetAttribute failed\n"); grid = -1; return; }
        if (hipOccupancyMaxActiveBlocksPerMultiprocessor(&per_cu, (const void*)mega_fwd, NWAVES * 64, LDS_BYTES) != hipSuccess || per_cu < 1) { fprintf(stderr, "kernel_launch: occupancy query gave %d\n", per_cu); (void)hipGetLastError(); per_cu = 1; }
        grid = cus * per_cu;
    }
    if (grid < 0) return;
    if (hipMemsetAsync((char*)d_ws + WS_CTL, 0, CTL_ZERO_BYTES, stream) != hipSuccess) { fprintf(stderr, "kernel_launch: memset failed\n"); return; }
    Args a{};
    for (int i = 0; i < 18; ++i) a.in[i] = (const float*)d_in[i];
    a.out = (float*)d_out; a.ws = (unsigned char*)d_ws;
#if MK_SPLIT
    for (int p = 0; p < N_PHASES; ++p) { a.ph_lo = p; a.ph_hi = p + 1; hipLaunchKernelGGL(mega_fwd, dim3(grid), dim3(NWAVES * 64), LDS_BYTES, stream, a); }
#else
    a.ph_lo = 0; a.ph_hi = N_PHASES;
    void* kargs[] = {&a};
    hipError_t e = hipLaunchCooperativeKernel((const void*)mega_fwd, dim3(grid), dim3(NWAVES * 64), kargs, LDS_BYTES, stream);
    if (e != hipSuccess) fprintf(stderr, "kernel_launch: cooperative launch failed: %s (grid %d)\n", hipGetErrorString(e), grid);
#endif
}
```
